# Optimizing an MI355X kernel written in HIP

```python
import jax, jax.numpy as jnp
from jax import lax
import numpy as np

D_MODEL = 1024
BATCH = 4
SEQ = 4096
DEPTH = 1

HEAD_DIM = 64
NSA_HEADS = 8
NSA_KV_HEADS = 2
SWA_HEADS = 8
SWA_KV_HEADS = 2
CMP_BLOCK = 32
CMP_STRIDE = 16
CMP_HIDDEN = 256
SLC_BLOCK = 64
N_SELECT = 16
NSA_WINDOW = 512
SWA_WINDOW = 128
Q_BLOCK = 128
RMS_EPS = 1e-6
NEG = -1e30
BIG = 1e30
NSA_WIDTH = NSA_HEADS * HEAD_DIM
SWA_WIDTH = SWA_HEADS * HEAD_DIM
KV_NSA = NSA_KV_HEADS * HEAD_DIM
KV_SWA = SWA_KV_HEADS * HEAD_DIM
SPLIT_SIZES = (NSA_WIDTH, 2 * KV_NSA, 2 * KV_NSA, 2 * KV_NSA, 3 * NSA_HEADS, NSA_WIDTH,
               SWA_WIDTH, 2 * KV_SWA, SWA_WIDTH, 2 * D_MODEL)
D_IN = sum(SPLIT_SIZES)

kernel_name = 'hybrid_nsa_swa_sink_gated_block'


def split_points():
    pts, acc = [], 0
    for s in SPLIT_SIZES[:-1]:
        acc += s
        pts.append(acc)
    return pts


def alibi_slopes(n, n_kv):
    s = 2.0 ** (-8.0 * (np.arange(n) + 1) / n)
    return jnp.asarray(s, dtype=jnp.float32).reshape(n_kv, n // n_kv)


def rms_norm(x, g):
    xf = x.astype(jnp.float32)
    y = xf * lax.rsqrt(jnp.mean(xf * xf, axis=-1, keepdims=True) + RMS_EPS)
    return (y * g.astype(jnp.float32)).astype(x.dtype)


def q_heads(t, n_kv, r):
    B, S, _ = t.shape
    return t.reshape(B, S, n_kv, r, HEAD_DIM).transpose(0, 2, 3, 1, 4)


def kv_heads(t, n_kv):
    B, S, _ = t.shape
    return t.reshape(B, S, n_kv, HEAD_DIM).transpose(0, 2, 1, 3)


def merge_heads(o):
    B, G, r, S, dh = o.shape
    return o.transpose(0, 3, 1, 2, 4).reshape(B, S, G * r * dh)


def banded_attention(q, k, v, slopes, window, sinks=None):
    B, G, r, S, dh = q.shape
    nprev = window // Q_BLOCK
    nqb = S // Q_BLOCK
    lk = (nprev + 1) * Q_BLOCK
    pad = nprev * Q_BLOCK
    kp = jnp.pad(k, ((0, 0), (0, 0), (pad, 0), (0, 0)))
    vp = jnp.pad(v, ((0, 0), (0, 0), (pad, 0), (0, 0)))
    idx = jnp.arange(nqb)[:, None] * Q_BLOCK + jnp.arange(lk)[None, :]
    kb = kp[:, :, idx].astype(jnp.float32)
    vb = vp[:, :, idx].astype(jnp.float32)
    qb = q.reshape(B, G, r, nqb, Q_BLOCK, dh).astype(jnp.float32)
    s = jnp.einsum('bgrnqd,bgnkd->bgrnqk', qb, kb) * (dh ** -0.5)
    qpos = jnp.arange(nqb)[:, None] * Q_BLOCK + jnp.arange(Q_BLOCK)[None, :]
    kpos = idx - pad
    dist = qpos[:, :, None] - kpos[:, None, :]
    valid = (dist >= 0) & (dist < window) & (kpos[:, None, :] >= 0)
    s = s - slopes[None, :, :, None, None, None] * dist.astype(jnp.float32)
    s = jnp.where(valid, s, NEG)
    if sinks is not None:
        sink = jnp.broadcast_to(sinks.astype(jnp.float32).reshape(1, G, r, 1, 1, 1), s.shape[:-1] + (1,))
        p = jax.nn.softmax(jnp.concatenate([s, sink], axis=-1), axis=-1)[..., :-1]
    else:
        p = jax.nn.softmax(s, axis=-1)
    o = jnp.einsum('bgrnqk,bgnkd->bgrnqd', p, vb)
    return o.reshape(B, G, r, S, dh).astype(q.dtype)


def compress_blocks(t, pe, w1, w2):
    B, G, S, dh = t.shape
    nc = (S - CMP_BLOCK) // CMP_STRIDE + 1
    idx = jnp.arange(nc)[:, None] * CMP_STRIDE + jnp.arange(CMP_BLOCK)[None, :]
    blk = t[:, :, idx] + pe
    flat = blk.reshape(B, G, nc, CMP_BLOCK * dh)
    return jax.nn.silu(flat @ w1) @ w2


def compressed_attention(q, kc, vc, slopes):
    B, G, r, S, dh = q.shape
    nc = kc.shape[2]
    s = jnp.einsum('bgrqd,bgcd->bgrqc', q.astype(jnp.float32), kc.astype(jnp.float32)) * (dh ** -0.5)
    end = jnp.arange(nc) * CMP_STRIDE + CMP_BLOCK - 1
    dist = jnp.arange(S)[:, None] - end[None, :]
    valid = dist >= 0
    s = s - slopes[None, :, :, None, None] * dist.astype(jnp.float32)
    s = jnp.where(valid, s, NEG)
    p = jax.nn.softmax(s, axis=-1) * jnp.any(valid, axis=-1)[:, None].astype(jnp.float32)
    o = jnp.einsum('bgrqc,bgcd->bgrqd', p, vc.astype(jnp.float32))
    return o.astype(q.dtype), p


def select_blocks(p_cmp):
    p = p_cmp.sum(axis=2)
    S, nc = p.shape[2], p.shape[3]
    nsb = S // SLC_BLOCK
    ratio = SLC_BLOCK // CMP_STRIDE
    span = CMP_BLOCK // CMP_STRIDE
    offs = (jnp.arange(ratio)[:, None] + jnp.arange(span)[None, :]).reshape(-1)
    cidx = ratio * jnp.arange(nsb)[:, None] - offs[None, :]
    ok = (cidx >= 0) & (cidx < nc)
    imp = jnp.where(ok, p[..., jnp.clip(cidx, 0, nc - 1)], 0.0).sum(axis=-1)
    cur = jnp.arange(S) // SLC_BLOCK
    j = jnp.arange(nsb)
    causal = j[None, :] <= cur[:, None]
    forced = (j[None, :] == 0) | (j[None, :] == cur[:, None]) | (j[None, :] == cur[:, None] - 1)
    score = jnp.where(causal & forced, BIG, jnp.where(causal, imp, NEG))
    _, idx = lax.top_k(score, min(N_SELECT, nsb))
    return idx


def selected_attention(q, k, v, blk_idx, slopes):
    B, G, r, S, dh = q.shape
    nsb = S // SLC_BLOCK
    n_sel = blk_idx.shape[-1]
    nqc = S // Q_BLOCK
    kb = k.reshape(B, G, nsb, SLC_BLOCK, dh)
    vb = v.reshape(B, G, nsb, SLC_BLOCK, dh)
    qc = q.reshape(B, G, r, nqc, Q_BLOCK, dh).transpose(3, 0, 1, 2, 4, 5)
    ic = blk_idx.reshape(B, G, nqc, Q_BLOCK, n_sel).transpose(2, 0, 1, 3, 4)
    qpos = jnp.arange(S).reshape(nqc, Q_BLOCK)
    gather = jax.vmap(jax.vmap(lambda blocks, ix: blocks[ix]))

    def one_block(args):
        q_i, ix, qp = args
        k_sel = gather(kb, ix).astype(jnp.float32)
        v_sel = gather(vb, ix).astype(jnp.float32)
        kpos = ix[..., None] * SLC_BLOCK + jnp.arange(SLC_BLOCK)
        dist = (qp[None, None, :, None, None] - kpos)[:, :, None]
        s = jnp.einsum('bgrqd,bgqnkd->bgrqnk', q_i.astype(jnp.float32), k_sel) * (dh ** -0.5)
        s = s - slopes[None, :, :, None, None, None] * dist.astype(jnp.float32)
        s = jnp.where(dist >= 0, s, NEG).reshape(B, G, r, Q_BLOCK, n_sel * SLC_BLOCK)
        p = jax.nn.softmax(s, axis=-1)
        return jnp.einsum('bgrqk,bgqkd->bgrqd', p, v_sel.reshape(B, G, Q_BLOCK, n_sel * SLC_BLOCK, dh))

    o = lax.map(one_block, (qc, ic, qpos))
    return o.transpose(1, 2, 3, 0, 4, 5).reshape(B, G, r, S, dh).astype(q.dtype)


def setup_inputs(seed: int = 0) -> dict:
    key = jax.random.key(seed)
    ks = jax.random.split(key, 20)
    D, L, dh = D_MODEL, DEPTH, HEAD_DIM
    nrm = lambda k, shape, fan: jax.random.normal(k, shape, jnp.float32) * (fan ** -0.5)
    return {
        'x': jax.random.normal(ks[0], (BATCH, SEQ, D), jnp.float32),
        'c': jax.random.normal(ks[1], (BATCH, D), jnp.float32),
        'w_ada': nrm(ks[2], (L, D, 3 * D), D) * 0.5,
        'b_ada': 0.01 * jax.random.normal(ks[3], (L, 3 * D), jnp.float32),
        'g_pre': 1.0 + 0.05 * jax.random.normal(ks[4], (L, D), jnp.float32),
        'g_post': 1.0 + 0.05 * jax.random.normal(ks[5], (L, D), jnp.float32),
        'w_in': nrm(ks[6], (L, D, D_IN), D),
        'pe_cmp_k': 0.02 * jax.random.normal(ks[7], (L, CMP_BLOCK, dh), jnp.float32),
        'pe_cmp_v': 0.02 * jax.random.normal(ks[8], (L, CMP_BLOCK, dh), jnp.float32),
        'w_cmp_k1': nrm(ks[9], (L, CMP_BLOCK * dh, CMP_HIDDEN), CMP_BLOCK * dh),
        'w_cmp_k2': nrm(ks[10], (L, CMP_HIDDEN, dh), CMP_HIDDEN),
        'w_cmp_v1': nrm(ks[11], (L, CMP_BLOCK * dh, CMP_HIDDEN), CMP_BLOCK * dh),
        'w_cmp_v2': nrm(ks[12], (L, CMP_HIDDEN, dh), CMP_HIDDEN),
        'w_o_nsa': nrm(ks[13], (L, NSA_WIDTH, D), NSA_WIDTH),
        'w_o_swa': nrm(ks[14], (L, SWA_WIDTH, D), SWA_WIDTH),
        'w_out': nrm(ks[15], (L, D, D), D),
        'sinks': jax.random.normal(ks[16], (L, SWA_HEADS), jnp.float32),
    }


def reference(x, c, w_ada, b_ada, g_pre, g_post, w_in, pe_cmp_k, pe_cmp_v, w_cmp_k1, w_cmp_k2,
              w_cmp_v1, w_cmp_v2, w_o_nsa, w_o_swa, w_out, sinks):
    B, S, D = x.shape
    ra = NSA_HEADS // NSA_KV_HEADS
    rb = SWA_HEADS // SWA_KV_HEADS
    slopes_a = alibi_slopes(NSA_HEADS, NSA_KV_HEADS)
    slopes_b = alibi_slopes(SWA_HEADS, SWA_KV_HEADS)
    pts = split_points()
    for l in range(DEPTH):
        mod = c @ w_ada[l] + b_ada[l]
        shift, scale, gate = jnp.split(mod, 3, axis=-1)
        h = rms_norm(x, g_pre[l]) * (1.0 + scale[:, None, :]) + shift[:, None, :]
        proj = h @ w_in[l]
        q_a, kv_c, kv_s, kv_w, g_nsa, z_a, q_b, kv_b, z_b, merge = jnp.split(proj, pts, axis=-1)

        qa = q_heads(q_a, NSA_KV_HEADS, ra)
        kc_raw, vc_raw = jnp.split(kv_c, 2, axis=-1)
        ks_, vs_ = jnp.split(kv_s, 2, axis=-1)
        kw_, vw_ = jnp.split(kv_w, 2, axis=-1)
        kc = compress_blocks(kv_heads(kc_raw, NSA_KV_HEADS), pe_cmp_k[l], w_cmp_k1[l], w_cmp_k2[l])
        vc = compress_blocks(kv_heads(vc_raw, NSA_KV_HEADS), pe_cmp_v[l], w_cmp_v1[l], w_cmp_v2[l])
        o_cmp, p_cmp = compressed_attention(qa, kc, vc, slopes_a)
        blk_idx = select_blocks(p_cmp)
        o_slc = selected_attention(qa, kv_heads(ks_, NSA_KV_HEADS), kv_heads(vs_, NSA_KV_HEADS), blk_idx, slopes_a)
        o_win = banded_attention(qa, kv_heads(kw_, NSA_KV_HEADS), kv_heads(vw_, NSA_KV_HEADS), slopes_a, NSA_WINDOW)
        gts = jax.nn.sigmoid(g_nsa.reshape(B, S, 3, NSA_KV_HEADS, ra)).transpose(2, 0, 3, 4, 1)[..., None]
        o_a = gts[0] * o_cmp + gts[1] * o_slc + gts[2] * o_win
        y_a = (merge_heads(o_a) * jax.nn.silu(z_a)) @ w_o_nsa[l]

        qb = q_heads(q_b, SWA_KV_HEADS, rb)
        kb_, vb_ = jnp.split(kv_b, 2, axis=-1)
        o_b = banded_attention(qb, kv_heads(kb_, SWA_KV_HEADS), kv_heads(vb_, SWA_KV_HEADS), slopes_b,
                               SWA_WINDOW, sinks=sinks[l])
        y_b = (merge_heads(o_b) * jax.nn.silu(z_b)) @ w_o_swa[l]

        m_a, m_b = jnp.split(merge, 2, axis=-1)
        y = (jax.nn.sigmoid(m_a) * y_a + jax.nn.sigmoid(m_b) * y_b) @ w_out[l]
        x = x + gate[:, None, :] * rms_norm(y, g_post[l])
    return x
```

```cpp
#include <hip/hip_runtime.h>
#include <hip/hip_cooperative_groups.h>
#include <cstdio>
namespace cg = cooperative_groups;

typedef unsigned short u16;
using bf16x8 = __attribute__((ext_vector_type(8))) short;
using bf16x4 = __attribute__((ext_vector_type(4))) short;
using f32x4 = __attribute__((ext_vector_type(4))) float;
using u32x4 = __attribute__((ext_vector_type(4))) unsigned;
using u32x2 = __attribute__((ext_vector_type(2))) unsigned;
typedef __bf16 bf16x2_t __attribute__((ext_vector_type(2)));
typedef float f32x2_t __attribute__((ext_vector_type(2)));

#define DI __device__ __forceinline__
#define MFMA16(a, b, c) __builtin_amdgcn_mfma_f32_16x16x32_bf16((a), (b), (c), 0, 0, 0)

constexpr int T_TOK = 16384, SEQ = 4096, DM = 1024, LDP = 4352, NIN = 5248;
constexpr float NEGF = -1e30f;
constexpr int C_QA = 0, C_KC = 512, C_ZA = 768, C_QB = 1280, C_ZB = 1792, C_MA = 2304, C_MB = 3328;

constexpr size_t OFF_P = 0;
constexpr size_t OFF_H = OFF_P + (size_t)T_TOK * LDP * 2;
constexpr size_t OFF_U = OFF_H + 33554432;
constexpr size_t OFF_VTS = OFF_U + 33554432;
constexpr size_t OFF_VTW = OFF_VTS + 4194304;
constexpr size_t OFF_VTB = OFF_VTW + 4194304;
constexpr size_t OFF_KS = OFF_VTB + 4194304;
constexpr size_t OFF_KW = OFF_KS + 4194304;
constexpr size_t OFF_KB = OFF_KW + 4194304;
constexpr size_t OFF_WTIN = OFF_KB + 4194304;
constexpr size_t OFF_WTOA = OFF_WTIN + (size_t)NIN * 1024 * 2;
constexpr size_t OFF_WTOB = OFF_WTOA + 1048576;
constexpr size_t OFF_WTOUT = OFF_WTOB + 1048576;
constexpr size_t OFF_WT1K = OFF_WTOUT + 2097152;
constexpr size_t OFF_WT1V = OFF_WT1K + 1048576;
constexpr size_t OFF_WT2K = OFF_WT1V + 1048576;
constexpr size_t OFF_WT2V = OFF_WT2K + 32768;
constexpr size_t OFF_KC = OFF_WT2V + 32768;
constexpr size_t OFF_VCT = OFF_KC + 262144;
constexpr size_t OFF_GN = OFF_VCT + 262144;
constexpr size_t OFF_MOD = OFF_GN + 1048576;
constexpr size_t OFF_BIAS1 = OFF_MOD + 49152;
constexpr size_t OFF_BAR = OFF_BIAS1 + 2048;
constexpr size_t OFF_MODP = OFF_BAR + 256;
constexpr size_t OFF_BIASP = OFF_MODP + 8 * 4 * 3072 * 4;
constexpr size_t WS_NEED = OFF_BIASP + 2 * 32 * 256 * 4;
static_assert(WS_NEED <= 268435456, "workspace layout exceeds 256 MiB");

struct Params {
  const float *x, *c, *w_ada, *b_ada, *g_pre, *g_post, *w_in, *pe_k, *pe_v, *w1k, *w2k, *w1v, *w2v,
      *w_o_nsa, *w_o_swa, *w_out, *sinks;
  float* out;
  char* ws;
};

DI unsigned pack2(float a, float b) {
  f32x2_t v = {a, b};
  bf16x2_t r = __builtin_convertvector(v, bf16x2_t);
  return __builtin_bit_cast(unsigned, r);
}
DI float bf2f(u16 h) { return __uint_as_float(((unsigned)h) << 16); }
DI float bflo(unsigned u) { return __uint_as_float(u << 16); }
DI float bfhi(unsigned u) { return __uint_as_float(u & 0xffff0000u); }
DI float sigmoidf_(float x) { return __builtin_amdgcn_rcpf(1.f + __expf(-x)); }
DI float siluf_(float x) { return x * __builtin_amdgcn_rcpf(1.f + __expf(-x)); }
DI float wave_sum(float v) {
#pragma unroll
  for (int o = 32; o >= 1; o >>= 1) v += __shfl_xor(v, o);
  return v;
}
DI int map_col(int n, int mode) {
  if (mode == 0) return n;
  if (n < 1280) return n;
  if (n < 5120) return n + 24;
  if (n < 5144) return 1280 + (n - 5120);
  return -1;
}
struct TDesc { const float* src; u16* dst; int K, N, kt, nt, mode; };

__device__ void phase0(const Params& p, char* smem) {
  const int half = threadIdx.x >> 8, t = threadIdx.x & 255;
  float* fs = (float*)smem + half * 4352;
  constexpr int N_IN = 16 * 82, N_OA = 8 * 16, N_OUT = 16 * 16, N_1 = 32 * 4, N_2 = 4, N_ADA = 384, N_B = 64;
  constexpr int E0 = N_IN, E1 = E0 + N_OA, E2 = E1 + N_OA, E3 = E2 + N_OUT, E4 = E3 + N_1, E5 = E4 + N_1,
                E6 = E5 + N_2, E7 = E6 + N_2, E8 = E7 + N_ADA, E9 = E8 + N_B;
  const int stride = gridDim.x * 2;
  const int rounds = (E9 + stride - 1) / stride;
  for (int it = 0; it < rounds; ++it) {
    const int item = it * stride + blockIdx.x * 2 + half;
    int kind = 3;
    TDesc d{};
    if (item < E7) {
      kind = 0;
      if (item < E0) d = TDesc{p.w_in, (u16*)(p.ws + OFF_WTIN), 1024, 5144, item / 82, item % 82, 1};
      else if (item < E1) { int i = item - E0; d = TDesc{p.w_o_nsa, (u16*)(p.ws + OFF_WTOA), 512, 1024, i / 16, i % 16, 0}; }
      else if (item < E2) { int i = item - E1; d = TDesc{p.w_o_swa, (u16*)(p.ws + OFF_WTOB), 512, 1024, i / 16, i % 16, 0}; }
      else if (item < E3) { int i = item - E2; d = TDesc{p.w_out, (u16*)(p.ws + OFF_WTOUT), 1024, 1024, i / 16, i % 16, 0}; }
      else if (item < E4) { int i = item - E3; d = TDesc{p.w1k, (u16*)(p.ws + OFF_WT1K), 2048, 256, i / 4, i % 4, 0}; }
      else if (item < E5) { int i = item - E4; d = TDesc{p.w1v, (u16*)(p.ws + OFF_WT1V), 2048, 256, i / 4, i % 4, 0}; }
      else if (item < E6) { int i = item - E5; d = TDesc{p.w2k, (u16*)(p.ws + OFF_WT2K), 256, 64, i, 0, 0}; }
      else { int i = item - E6; d = TDesc{p.w2v, (u16*)(p.ws + OFF_WT2V), 256, 64, i, 0, 0}; }
    } else if (item < E8) kind = 1;
    else if (item < E9) kind = 2;

    if (kind == 0) {
      const int tx = t & 63, ty = t >> 6;
      const int k0 = d.kt * 64, n0 = d.nt * 64;
      const int sc = map_col(n0 + tx, d.mode);
#pragma unroll
      for (int i = 0; i < 16; ++i) {
        int k = ty + 4 * i;
        fs[k * 65 + tx] = (sc >= 0) ? d.src[(size_t)(k0 + k) * d.N + sc] : 0.f;
      }
    } else if (kind == 1) {
      const int ai = item - E7, q = ai / 48;
      int n0 = (ai % 48) * 64, col = t & 63, kg = t >> 6;
      float a0 = 0.f, a1 = 0.f, a2 = 0.f, a3 = 0.f;
#pragma unroll 8
      for (int i = 0; i < 32; ++i) {
        const int k = q * 128 + kg + 4 * i;
        float w = p.w_ada[(size_t)k * 3072 + n0 + col];
        a0 += p.c[k] * w; a1 += p.c[1024 + k] * w; a2 += p.c[2048 + k] * w; a3 += p.c[3072 + k] * w;
      }
      fs[(kg * 4 + 0) * 64 + col] = a0; fs[(kg * 4 + 1) * 64 + col] = a1;
      fs[(kg * 4 + 2) * 64 + col] = a2; fs[(kg * 4 + 3) * 64 + col] = a3;
    }
    __syncthreads();
    if (kind == 0) {
      const int k0 = d.kt * 64, n0 = d.nt * 64;
      const int c2 = t & 31, r = t >> 5;
#pragma unroll
      for (int i = 0; i < 8; ++i) {
        int rr = r + 8 * i;
        unsigned v = pack2(fs[(2 * c2) * 65 + rr], fs[(2 * c2 + 1) * 65 + rr]);
        *(unsigned*)(d.dst + (size_t)(n0 + rr) * d.K + k0 + 2 * c2) = v;
      }
    } else if (kind == 1) {
      const int ai = item - E7, q = ai / 48;
      int n0 = (ai % 48) * 64, col = t & 63, b = t >> 6;
      float s = fs[(0 * 4 + b) * 64 + col] + fs[(1 * 4 + b) * 64 + col] + fs[(2 * 4 + b) * 64 + col] +
                fs[(3 * 4 + b) * 64 + col];
      ((float*)(p.ws + OFF_MODP))[(q * 4 + b) * 3072 + n0 + col] = s;
    } else if (kind == 2) {
      const int bi = item - E8, kv = bi >> 5, kc = bi & 31;
      const float* pe = (kv ? p.pe_v : p.pe_k) + kc * 64;
      const float* w1 = (kv ? p.w1v : p.w1k) + (size_t)kc * 64 * 256;
      float a = 0.f;
#pragma unroll 16
      for (int k = 0; k < 64; ++k) a += pe[k] * w1[(size_t)k * 256 + t];
      ((float*)(p.ws + OFF_BIASP))[(kv * 32 + kc) * 256 + t] = a;
    }
    __syncthreads();
  }
}

DI float mod_value(const Params& p, int b, int idx) {
  const float* mp = (const float*)(p.ws + OFF_MODP) + b * 3072 + idx;
  float s = p.b_ada[idx];
#pragma unroll
  for (int q = 0; q < 8; ++q) s += mp[q * 4 * 3072];
  return s;
}
__device__ void phase1(const Params& p, char* smem) {
  const int t = threadIdx.x, lane = t & 63, wave = t >> 6;
  float* gs = (float*)smem;
  float* sh = gs + 1024;
  u16* H = (u16*)(p.ws + OFF_H);
  for (int row0 = blockIdx.x * 64; row0 < T_TOK; row0 += gridDim.x * 64) {
    const int b = row0 >> 12;
    __syncthreads();
    for (int c = t; c < 1024; c += 512) {
      sh[c] = mod_value(p, b, c);
      gs[c] = p.g_pre[c] * (1.f + mod_value(p, b, 1024 + c));
    }
    __syncthreads();
#pragma unroll 2
    for (int rr = 0; rr < 8; ++rr) {
      const int row = row0 + wave * 8 + rr;
      const float4* xr = (const float4*)(p.x + (size_t)row * 1024);
      float4 v[4];
      float ss = 0.f;
#pragma unroll
      for (int i = 0; i < 4; ++i) {
        v[i] = xr[lane + 64 * i];
        ss += v[i].x * v[i].x + v[i].y * v[i].y + v[i].z * v[i].z + v[i].w * v[i].w;
      }
      ss = wave_sum(ss);
      const float rstd = rsqrtf(ss * (1.f / 1024.f) + 1e-6f);
#pragma unroll
      for (int i = 0; i < 4; ++i) {
        const int cidx = lane + 64 * i;
        float4 g = ((const float4*)gs)[cidx];
        float4 s4 = ((const float4*)sh)[cidx];
        float h0 = v[i].x * rstd * g.x + s4.x;
        float h1 = v[i].y * rstd * g.y + s4.y;
        float h2 = v[i].z * rstd * g.z + s4.z;
        float h3 = v[i].w * rstd * g.w + s4.w;
        u32x2 o = {pack2(h0, h1), pack2(h2, h3)};
        *(u32x2*)(H + (size_t)row * 1024 + cidx * 4) = o;
      }
    }
  }
}
constexpr int G_STAGE = 32768;
constexpr int SMEM_BYTES = 139264;

DI void glds16(const void* g, char* lds_wave_base) {
  __builtin_amdgcn_global_load_lds((const unsigned*)g, (unsigned*)lds_wave_base, 16, 0, 0);
}
DI int swz_g(int x) { return (0x78 >> (2 * x)) & 3; }

DI void zero_acc84(f32x4 (&acc)[8][4]) {
#pragma unroll
  for (int i = 0; i < 8; ++i)
#pragma unroll
    for (int j = 0; j < 4; ++j) acc[i][j] = (f32x4){0.f, 0.f, 0.f, 0.f};
}
DI void zero_acc(f32x4 (&acc)[4][4]) {
#pragma unroll
  for (int i = 0; i < 4; ++i)
#pragma unroll
    for (int j = 0; j < 4; ++j) acc[i][j] = (f32x4){0.f, 0.f, 0.f, 0.f};
}

template <bool HASMID, class Geom, class Mid, class Epi>
DI void gemm_stream(const Geom& geom, const Mid& mid, const Epi& epi, char* smem) {
  constexpr int NK = 32;
  const int t = threadIdx.x, lane = t & 63, wave = __builtin_amdgcn_readfirstlane(t >> 6);
  const int wm = wave >> 2, wn = wave & 3, quad = lane >> 4, l15 = lane & 15;
  const int total = geom.count() * NK;
  const int lr = lane >> 2;
  const int lc = ((lane & 3) ^ swz_g((lane >> 4) & 3)) * 8;

  auto issue = [&](int g, int stg) {
    const int tile = geom.tile_of(g >> 5), kt = g & (NK - 1);
    const u16 *a, *b;
    int lda, ldb;
    geom.ptrs(tile, kt, a, lda, b, ldb);
    char* st = smem + stg * G_STAGE + wave * 4096;
    const u16* src = (wave < 4) ? a + (size_t)(wave * 64 + lr) * lda + lc : b + (size_t)((wave - 4) * 64 + lr) * ldb + lc;
    const int ld = (wave < 4) ? lda : ldb;
#pragma unroll
    for (int i = 0; i < 4; ++i) glds16(src + (size_t)(i * 16) * ld, st + i * 1024);
  };

  __syncthreads();
  if (total > 0) { issue(0, 0); issue(1, 1); issue(2, 2); }
  f32x4 acc[8][4];
  zero_acc84(acc);
  const int rpos = (quad ^ swz_g(l15 >> 2)) * 16;
  const int aoff = (wm * 128 + l15) * 64 + rpos;
  const int boff = 16384 + (wn * 64 + l15) * 64 + rpos;
  int sidx = 0, g = 0;
  auto step = [&]() {
    if (g + 2 < total) asm volatile("s_waitcnt vmcnt(8)" ::: "memory");
    else if (g + 1 < total) asm volatile("s_waitcnt vmcnt(4)" ::: "memory");
    else asm volatile("s_waitcnt vmcnt(0)" ::: "memory");
    asm volatile("s_waitcnt lgkmcnt(0)" ::: "memory");
    __builtin_amdgcn_s_barrier();
    if (g + 3 < total) issue(g + 3, (sidx + 3) & 3);
    const char* st = smem + sidx * G_STAGE;
    bf16x8 bfr[4], af[8];
#pragma unroll
    for (int j = 0; j < 4; ++j) bfr[j] = *(const bf16x8*)(st + boff + j * 1024);
#pragma unroll
    for (int i = 0; i < 8; ++i) af[i] = *(const bf16x8*)(st + aoff + i * 1024);
#pragma unroll
    for (int i = 0; i < 8; ++i)
#pragma unroll
      for (int j = 0; j < 4; ++j) acc[i][j] = MFMA16(bfr[j], af[i], acc[i][j]);
    sidx = (sidx + 1) & 3;
    ++g;
  };
  const int ntile = geom.count();
  for (int tj = 0; tj < ntile; ++tj) {
    const int tile = geom.tile_of(tj);
    for (int kt = 0; kt < NK / 2; ++kt) step();
    if (HASMID) mid(tile, acc);
    for (int kt = NK / 2; kt < NK; ++kt) step();
    epi(tile, acc);
    zero_acc84(acc);
  }
  __syncthreads();
}

struct Geom2 {
  const u16 *H, *W;
  DI int count() const {
    if (gridDim.x != 256) return ((int)blockIdx.x < 1280) ? (1279 - (int)blockIdx.x) / (int)gridDim.x + 1 : 0;
    return 5;
  }
  DI int tile_of(int j) const {
    if (gridDim.x != 256) return blockIdx.x + j * gridDim.x;
    const int x = blockIdx.x & 7, s = blockIdx.x >> 3;
    return (8 * x + (s & 7)) * 20 + 4 * j + (s >> 3);
  }
  DI void ptrs(int tile, int kt, const u16*& a, int& lda, const u16*& b, int& ldb) const {
    const int m0 = (tile / 20) * 256, n0 = (tile % 20) * 256;
    a = H + (size_t)m0 * 1024 + kt * 32; lda = 1024;
    b = W + (size_t)n0 * 1024 + kt * 32; ldb = 1024;
  }
};

__device__ void phase2(const Params& p, char* smem) {
  Geom2 geom{(const u16*)(p.ws + OFF_H), (const u16*)(p.ws + OFF_WTIN)};
  u16* P = (u16*)(p.ws + OFF_P);
  char* ws = p.ws;
  const int t = threadIdx.x, lane = t & 63, wave = t >> 6, wm = wave >> 2, wn = wave & 3, quad_ = lane >> 4,
            l15_ = lane & 15;
  auto epi = [&](int tile, f32x4 (&acc)[8][4]) {
    int l15 = l15_, quad = quad_;
    asm volatile("" : "+v"(l15), "+v"(quad));
    const int m0 = (tile / 20) * 256, n0 = (tile % 20) * 256;
    const int nc0 = n0 + wn * 64, cg = nc0 >> 6;
    const bool vgrp = (cg == 14) || (cg == 15) || (cg == 18) || (cg == 19) || (cg == 38) || (cg == 39);
    if (vgrp) {
      u16* VT = (u16*)(ws + (cg < 16 ? OFF_VTS : (cg < 20 ? OFF_VTW : OFF_VTB)));
      const int grp = cg & 1;
      const int b = m0 >> 12;
#pragma unroll
      for (int i = 0; i < 8; ++i)
#pragma unroll
        for (int j = 0; j < 4; ++j) {
          const int tok = m0 + wm * 128 + i * 16 + l15;
          const int s = tok & 4095;
          const int d = j * 16 + quad * 4;
          u16* dst = VT + (size_t)(b * 2 + grp) * (64 * 4096) + (size_t)(s >> 5) * 2048 + d * 32 + (s & 31);
          unsigned p01 = pack2(acc[i][j][0], acc[i][j][1]), p23 = pack2(acc[i][j][2], acc[i][j][3]);
          dst[0] = (u16)(p01 & 0xffffu);
          dst[32] = (u16)(p01 >> 16);
          dst[64] = (u16)(p23 & 0xffffu);
          dst[96] = (u16)(p23 >> 16);
        }
    } else {
      int mode;
      u16* dstb;
      int dld;
      const int bgrow = (m0 >> 12) * 2;
      if (cg < 8) { mode = 1; dstb = P + C_QA + cg * 64; dld = LDP; }
      else if (cg < 12) { mode = 0; dstb = P + C_KC + (cg - 8) * 64; dld = LDP; }
      else if (cg < 20) {
        mode = 0;
        dstb = (u16*)(ws + (cg < 16 ? OFF_KS : OFF_KW)) + (size_t)(bgrow + (cg & 1)) * 4096 * 64 - (size_t)(m0 & ~4095) * 64;
        dld = 64;
      }
      else if (cg < 28) { mode = 2; dstb = P + C_ZA + (cg - 20) * 64; dld = LDP; }
      else if (cg < 36) { mode = 1; dstb = P + C_QB + (cg - 28) * 64; dld = LDP; }
      else if (cg < 40) {
        mode = 0;
        dstb = (u16*)(ws + OFF_KB) + (size_t)(bgrow + (cg & 1)) * 4096 * 64 - (size_t)(m0 & ~4095) * 64;
        dld = 64;
      }
      else if (cg < 48) { mode = 2; dstb = P + C_ZB + (cg - 40) * 64; dld = LDP; }
      else { mode = 3; dstb = P + C_MA + (cg - 48) * 64; dld = LDP; }
      const bool lin_one = (mode == 3), use_sig = (mode >= 2);
      const float mul = (mode == 1) ? 0.125f * 1.44269504f : 1.f;
#pragma unroll
      for (int i = 0; i < 8; ++i)
#pragma unroll
        for (int j = 0; j < 4; ++j) {
          const int tok = m0 + wm * 128 + i * 16 + l15;
          const int n = j * 16 + quad * 4;
          const float a0 = acc[i][j][0], a1 = acc[i][j][1], a2 = acc[i][j][2], a3 = acc[i][j][3];
          const float s0 = sigmoidf_(a0), s1 = sigmoidf_(a1), s2 = sigmoidf_(a2), s3 = sigmoidf_(a3);
          const float v0 = (lin_one ? 1.f : a0 * mul) * (use_sig ? s0 : 1.f);
          const float v1 = (lin_one ? 1.f : a1 * mul) * (use_sig ? s1 : 1.f);
          const float v2 = (lin_one ? 1.f : a2 * mul) * (use_sig ? s2 : 1.f);
          const float v3 = (lin_one ? 1.f : a3 * mul) * (use_sig ? s3 : 1.f);
          u32x2 o = {pack2(v0, v1), pack2(v2, v3)};
          *(u32x2*)(dstb + (size_t)tok * dld + n) = o;
        }
    }
  };
  auto nomid = [](int, f32x4 (&)[8][4]) {};
  gemm_stream<false>(geom, nomid, epi, smem);

  const int l15 = l15_, quad = quad_;
  {
    const u16* H = geom.H;
    const u16* Wg = geom.W + (size_t)5120 * 1024;
    u16* GN = (u16*)(ws + OFF_GN);
    const int nwv = gridDim.x * 8;
    for (int it = blockIdx.x * 8 + wave; it < 1024; it += nwv) {
      const int tok0 = it * 16;
      f32x4 c0 = (f32x4){0.f, 0.f, 0.f, 0.f}, c1 = c0;
      const u16* hp = H + (size_t)(tok0 + l15) * 1024 + quad * 8;
      const u16* wp = Wg + (size_t)l15 * 1024 + quad * 8;
#pragma unroll 8
      for (int ks = 0; ks < 32; ++ks) {
        bf16x8 hf = *(const bf16x8*)(hp + ks * 32);
        bf16x8 w0 = *(const bf16x8*)(wp + ks * 32);
        bf16x8 w1 = *(const bf16x8*)(wp + 16 * 1024 + ks * 32);
        c0 = MFMA16(w0, hf, c0);
        c1 = MFMA16(w1, hf, c1);
      }
      u32x2 o0 = {pack2(sigmoidf_(c0[0]), sigmoidf_(c0[1])), pack2(sigmoidf_(c0[2]), sigmoidf_(c0[3]))};
      u32x2 o1 = {pack2(sigmoidf_(c1[0]), sigmoidf_(c1[1])), pack2(sigmoidf_(c1[2]), sigmoidf_(c1[3]))};
      *(u32x2*)(GN + (size_t)(tok0 + l15) * 32 + quad * 4) = o0;
      *(u32x2*)(GN + (size_t)(tok0 + l15) * 32 + 16 + quad * 4) = o1;
    }
  }
}

__device__ void phase3(const Params& p, char* smem) {
  const u16* P = (const u16*)(p.ws + OFF_P);
  const float* bias1 = (const float*)(p.ws + OFF_BIASP);
  const int t = threadIdx.x, lane = t & 63, wave = t >> 6, quad = lane >> 4, l15 = lane & 15;
  u16* hs = (u16*)smem;
  for (int item = blockIdx.x; item < 256; item += gridDim.x) {
    const int kv = item >> 7, bg = (item >> 4) & 7, ct = item & 15;
    const int b = bg >> 1, g = bg & 1, c0 = ct * 16;
    const u16* Wt1 = (const u16*)(p.ws + (kv ? OFF_WT1V : OFF_WT1K));
    const u16* Wt2 = (const u16*)(p.ws + (kv ? OFF_WT2V : OFF_WT2K));
    const int col0 = C_KC + kv * 128 + g * 64;
    const int crow = c0 + l15;
    f32x4 acc[2];
    acc[0] = (f32x4){0.f, 0.f, 0.f, 0.f};
    acc[1] = acc[0];
    const u16* wb = Wt1 + (size_t)(wave * 32 + l15) * 2048 + quad * 8;
#pragma unroll 8
    for (int ks = 0; ks < 64; ++ks) {
      int tokl = 16 * crow + (ks >> 1);
      tokl = tokl > 4095 ? 4095 : tokl;
      bf16x8 af = *(const bf16x8*)(P + (size_t)(b * 4096 + tokl) * LDP + col0 + (ks & 1) * 32 + quad * 8);
#pragma unroll
      for (int j = 0; j < 2; ++j) {
        bf16x8 bfr = *(const bf16x8*)(wb + (size_t)(j * 16) * 2048 + ks * 32);
        acc[j] = MFMA16(af, bfr, acc[j]);
      }
    }
    __syncthreads();
#pragma unroll
    for (int j = 0; j < 2; ++j) {
      const int n = wave * 32 + j * 16 + l15;
      float bb = 0.f;
#pragma unroll 8
      for (int kc = 0; kc < 32; ++kc) bb += bias1[(kv * 32 + kc) * 256 + n];
#pragma unroll
      for (int r = 0; r < 4; ++r) {
        float hval = siluf_(acc[j][r] + bb);
        hs[(quad * 4 + r) * 264 + n] = (u16)(pack2(hval, 0.f) & 0xffffu);
      }
    }
    __syncthreads();
    if (wave < 4) {
      f32x4 o = (f32x4){0.f, 0.f, 0.f, 0.f};
#pragma unroll
      for (int ks = 0; ks < 8; ++ks) {
        bf16x8 hf = *(const bf16x8*)(hs + l15 * 264 + ks * 32 + quad * 8);
        bf16x8 wf = *(const bf16x8*)(Wt2 + (size_t)(wave * 16 + l15) * 256 + ks * 32 + quad * 8);
        if (kv == 0) o = MFMA16(wf, hf, o);
        else o = MFMA16(hf, wf, o);
      }
      if (kv == 0) {
        u16* KC = (u16*)(p.ws + OFF_KC);
        const int c = c0 + l15;
        u32x2 ov = {pack2(o[0], o[1]), pack2(o[2], o[3])};
        if (c == 255) ov = (u32x2){0u, 0u};
        *(u32x2*)(KC + (size_t)(bg * 256 + c) * 64 + wave * 16 + quad * 4) = ov;
      } else {
        u16* VCT = (u16*)(p.ws + OFF_VCT);
        const int cb = c0 + quad * 4;
        float o3 = (cb + 3 == 255) ? 0.f : o[3];
        u32x2 ov = {pack2(o[0], o[1]), pack2(o[2], o3)};
        *(u32x2*)(VCT + (size_t)(bg * 64 + wave * 16 + l15) * 256 + cb) = ov;
      }
    }
  }
}

struct QF {
  const char* base;
  DI bf16x8 get(int nt, int kk) const {
    int off = (nt * 2 + kk) * 1024;
    asm volatile("" : "+v"(off));
    return *(const bf16x8*)(base + off);
  }
};

DI void load_q(QF& qf, char* qslot, const u16* P, int tokbase, int qcol, int lane) {
  const u16* q = P + (size_t)(tokbase + (lane & 15)) * LDP + qcol + (lane >> 4) * 8;
  char* dst = qslot + lane * 16;
#pragma unroll
  for (int nt = 0; nt < 4; ++nt) {
    *(bf16x8*)(dst + (nt * 2 + 0) * 1024) = *(const bf16x8*)(q + nt * 64);
    *(bf16x8*)(dst + (nt * 2 + 1) * 1024) = *(const bf16x8*)(q + nt * 64 + 32);
  }
  qf.base = dst;
}

DI void qk_step(const QF& qf, const u16* kptr, size_t kstride, int lane, f32x4 (&s)[2][4]) {
#pragma unroll
  for (int kt2 = 0; kt2 < 2; ++kt2) {
    const u16* kp = kptr + (size_t)(kt2 * 16 + (lane & 15)) * kstride + (lane >> 4) * 8;
    bf16x8 k0 = *(const bf16x8*)(kp), k1 = *(const bf16x8*)(kp + 32);
#pragma unroll
    for (int nt = 0; nt < 4; ++nt) {
      f32x4 z = (f32x4){0.f, 0.f, 0.f, 0.f};
      z = MFMA16(k0, qf.get(nt, 0), z);
      s[kt2][nt] = MFMA16(k1, qf.get(nt, 1), z);
    }
  }
}

DI void pv_step(const bf16x8 (&pf)[4], const u16* vtptr, size_t vtstride, int lane, f32x4 (&o)[4][4]) {
#pragma unroll
  for (int dt = 0; dt < 4; ++dt) {
    const u16* vp = vtptr + (size_t)(dt * 16 + (lane & 15)) * vtstride + (lane >> 4) * 4;
    bf16x4 lo = *(const bf16x4*)vp, hi = *(const bf16x4*)(vp + 16);
    bf16x8 vf = __builtin_shufflevector(lo, hi, 0, 1, 2, 3, 4, 5, 6, 7);
#pragma unroll
    for (int nt = 0; nt < 4; ++nt) o[dt][nt] = MFMA16(vf, pf[nt], o[dt][nt]);
  }
}

DI bf16x8 pack8(const float (&pv)[8]) {
  unsigned a = pack2(pv[0], pv[1]), b = pack2(pv[2], pv[3]), c = pack2(pv[4], pv[5]), d = pack2(pv[6], pv[7]);
  u32x4 u = {a, b, c, d};
  return __builtin_bit_cast(bf16x8, u);
}

DI float ex2(float x) { return __builtin_amdgcn_exp2f(x); }

struct KV { bf16x8 kf[2][2]; const u16* vp; };
DI void load_kv(KV& kv, const u16* kptr, size_t kstride, const u16* vtptr, size_t vtstride, int lane) {
#pragma unroll
  for (int kt2 = 0; kt2 < 2; ++kt2) {
    const u16* kp = kptr + (size_t)(kt2 * 16 + (lane & 15)) * kstride + (lane >> 4) * 8;
    kv.kf[kt2][0] = *(const bf16x8*)(kp);
    kv.kf[kt2][1] = *(const bf16x8*)(kp + 32);
  }
  kv.vp = vtptr + (size_t)(lane & 15) * vtstride + (lane >> 4) * 4;
}

template <class MaskF>
DI void attn_compute(const QF& qf, const KV& kv, size_t vtstride, const float (&slope)[4], float (&m)[4],
                     float (&l)[4], f32x4 (&o)[4][4], bool allvalid, MaskF maskf) {
  bf16x8 vf[4];
#pragma unroll
  for (int dt = 0; dt < 4; ++dt) {
    const u16* vp = kv.vp + (size_t)(dt * 16) * vtstride;
    bf16x4 lo = *(const bf16x4*)vp, hi = *(const bf16x4*)(vp + 16);
    vf[dt] = __builtin_shufflevector(lo, hi, 0, 1, 2, 3, 4, 5, 6, 7);
  }
  float fd[8];
  bool valid[8];
#pragma unroll
  for (int kt2 = 0; kt2 < 2; ++kt2)
#pragma unroll
    for (int r = 0; r < 4; ++r) maskf(kt2, r, fd[kt2 * 4 + r], valid[kt2 * 4 + r]);
  bf16x8 pf[4];
#pragma unroll
  for (int nt = 0; nt < 4; ++nt) {
    f32x4 s0 = (f32x4){0.f, 0.f, 0.f, 0.f}, s1 = s0;
    const bf16x8 q0 = qf.get(nt, 0), q1 = qf.get(nt, 1);
    s0 = MFMA16(kv.kf[0][0], q0, s0);
    s0 = MFMA16(kv.kf[0][1], q1, s0);
    s1 = MFMA16(kv.kf[1][0], q0, s1);
    s1 = MFMA16(kv.kf[1][1], q1, s1);
    float sv[8];
    float mx = NEGF;
    if (allvalid) {
#pragma unroll
      for (int r = 0; r < 4; ++r) {
        sv[r] = s0[r] - slope[nt] * fd[r];
        sv[4 + r] = s1[r] - slope[nt] * fd[4 + r];
        mx = fmaxf(mx, fmaxf(sv[r], sv[4 + r]));
      }
    } else {
#pragma unroll
      for (int r = 0; r < 4; ++r) {
        sv[r] = valid[r] ? s0[r] - slope[nt] * fd[r] : NEGF;
        sv[4 + r] = valid[4 + r] ? s1[r] - slope[nt] * fd[4 + r] : NEGF;
        mx = fmaxf(mx, fmaxf(sv[r], sv[4 + r]));
      }
    }
    if (__any(mx > m[nt] + 8.f)) {
      mx = fmaxf(mx, __shfl_xor(mx, 16));
      mx = fmaxf(mx, __shfl_xor(mx, 32));
      const float mnew = fmaxf(m[nt], mx);
      const float alpha = ex2(m[nt] - mnew);
      m[nt] = mnew;
      l[nt] *= alpha;
#pragma unroll
      for (int dt = 0; dt < 4; ++dt) o[dt][nt] *= alpha;
    }
    float pv[8];
    float ps = 0.f;
    if (allvalid) {
#pragma unroll
      for (int i = 0; i < 8; ++i) {
        pv[i] = ex2(sv[i] - m[nt]);
        ps += pv[i];
      }
    } else {
#pragma unroll
      for (int i = 0; i < 8; ++i) {
        pv[i] = valid[i] ? ex2(sv[i] - m[nt]) : 0.f;
        ps += pv[i];
      }
    }
    l[nt] += ps;
    pf[nt] = pack8(pv);
  }
#pragma unroll
  for (int dt = 0; dt < 4; ++dt)
#pragma unroll
    for (int nt = 0; nt < 4; ++nt) o[dt][nt] = MFMA16(vf[dt], pf[nt], o[dt][nt]);
}

template <class NextF, class LoadF, class CompF>
DI void attn_pipeline(NextF next, LoadF load, CompF comp) {
  int k0 = next();
  if (k0 < 0) return;
  KV cur;
  load(cur, k0);
  while (true) {
    const int k1 = next();
    KV nxt = cur;
    if (k1 >= 0) load(nxt, k1);
    comp(cur, k0);
    if (k1 < 0) break;
    cur = nxt;
    k0 = k1;
  }
}

DI void softmax_step(f32x4 (&s)[2][4], float (&m)[4], float (&l)[4], f32x4 (&o)[4][4], bf16x8 (&pf)[4]) {
#pragma unroll
  for (int nt = 0; nt < 4; ++nt) {
    float mx = NEGF;
#pragma unroll
    for (int kt2 = 0; kt2 < 2; ++kt2)
#pragma unroll
      for (int r = 0; r < 4; ++r) mx = fmaxf(mx, s[kt2][nt][r]);
    mx = fmaxf(mx, __shfl_xor(mx, 16));
    mx = fmaxf(mx, __shfl_xor(mx, 32));
    const float mnew = fmaxf(m[nt], mx);
    const float alpha = __expf(m[nt] - mnew);
    m[nt] = mnew;
    float pv[8];
    float ps = 0.f;
#pragma unroll
    for (int kt2 = 0; kt2 < 2; ++kt2)
#pragma unroll
      for (int r = 0; r < 4; ++r) {
        float sv = s[kt2][nt][r];
        float e = (sv > -5e29f) ? __expf(sv - mnew) : 0.f;
        pv[kt2 * 4 + r] = e;
        ps += e;
      }
    l[nt] = l[nt] * alpha + ps;
#pragma unroll
    for (int dt = 0; dt < 4; ++dt) o[dt][nt] *= alpha;
    pf[nt] = pack8(pv);
  }
}

DI void init_state(float (&m)[4], float (&l)[4], f32x4 (&o)[4][4]) {
#pragma unroll
  for (int nt = 0; nt < 4; ++nt) { m[nt] = NEGF; l[nt] = 0.f; }
  zero_acc(o);
}
DI float quad_sum(float v) { v += __shfl_xor(v, 16); v += __shfl_xor(v, 32); return v; }

DI void accum_gated(f32x4 (&tot)[4][4], const f32x4 (&o)[4][4], const float (&l)[4], const float (&gate)[4]) {
#pragma unroll
  for (int nt = 0; nt < 4; ++nt) {
    float lt = quad_sum(l[nt]);
    float sc = lt > 0.f ? gate[nt] / lt : 0.f;
#pragma unroll
    for (int dt = 0; dt < 4; ++dt) tot[dt][nt] += o[dt][nt] * sc;
  }
}

template <int W>
DI void banded_attn(const QF& qf, const u16* kbase, int t0, const u16* vt, int lane,
                    const float (&slope)[4], float (&m)[4], float (&l)[4], f32x4 (&o)[4][4]) {
  const int tok = t0 + (lane & 15), quad = lane >> 4;
  int kstart = t0 - (W - 1);
  kstart = kstart < 0 ? 0 : (kstart & ~31);
  int knext = kstart;
  attn_pipeline(
      [&]() { int k = knext; knext += 32; return (k <= t0 + 15) ? k : -1; },
      [&](KV& kv, int key0) { load_kv(kv, kbase + (size_t)key0 * 64, 64, vt + (size_t)key0 * 64, 32, lane); },
      [&](const KV& kv, int key0) {
        attn_compute(qf, kv, 32, slope, m, l, o, (key0 + 31 <= t0) && (key0 >= t0 + 15 - (W - 1)),
                     [&](int kt2, int r, float& fd, bool& valid) {
                       const int dist = tok - (key0 + kt2 * 16 + quad * 4 + r);
                       valid = (dist >= 0) && (dist < W);
                       fd = (float)dist;
                     });
      });
}
DI void tot_store(float* TOT, size_t grow, int g, int quad, const f32x4 (&o)[4][4], const float (&sc)[4], bool add) {
#pragma unroll
  for (int nt = 0; nt < 4; ++nt)
#pragma unroll
    for (int dt = 0; dt < 4; ++dt) {
      f32x4* ptr = (f32x4*)(TOT + grow * 512 + (g * 4 + nt) * 64 + dt * 16 + quad * 4);
      f32x4 v = o[dt][nt] * sc[nt];
      if (add) v += *ptr;
      *ptr = v;
    }
}

__device__ void nsa_item(const Params& p, int item, char* smem) {
  const u16* P = (const u16*)(p.ws + OFF_P);
  const u16* GN = (const u16*)(p.ws + OFF_GN);
  float* TOT = (float*)(p.ws + OFF_U);
  const int t = threadIdx.x, lane = t & 63, wave = t >> 6, quad = lane >> 4, l15 = lane & 15;
  const int bg = item >> 5, tb0 = (item & 31) * 128;
  const int b = bg >> 1, g = bg & 1;
  const int t0 = tb0 + wave * 16, tok = t0 + l15;
  const size_t grow = (size_t)(b * 4096 + tok);
  QF qf;
  load_q(qf, smem + 66560 + wave * 8192, P, b * 4096 + t0, C_QA + g * 256, lane);
  float slope[4];
#pragma unroll
  for (int nt = 0; nt < 4; ++nt) slope[nt] = exp2f(-(float)(g * 4 + nt + 1)) * 1.44269504f;
  float m[4], l[4];
  f32x4 o[4][4];
  float gate[4];

  const u16* KC = (const u16*)(p.ws + OFF_KC) + (size_t)bg * 256 * 64;
  const u16* VCT = (const u16*)(p.ws + OFF_VCT) + (size_t)bg * 64 * 256;
  const int ncv = (tb0 + 127 >= 31) ? (((tb0 + 127 - 31) >> 4) + 1) : 0;
  const int steps = (ncv + 31) >> 5;
#pragma unroll
  for (int nt = 0; nt < 4; ++nt) { m[nt] = NEGF; l[nt] = 0.f; }
  for (int st = 0; st < steps; ++st) {
    f32x4 s[2][4];
    qk_step(qf, KC + (size_t)(st * 32) * 64, 64, lane, s);
#pragma unroll
    for (int nt = 0; nt < 4; ++nt) {
      float mx = NEGF;
#pragma unroll
      for (int kt2 = 0; kt2 < 2; ++kt2)
#pragma unroll
        for (int r = 0; r < 4; ++r) {
          const int c = st * 32 + kt2 * 16 + quad * 4 + r;
          const int dist = tok - (16 * c + 31);
          float sv = (dist >= 0) ? s[kt2][nt][r] - slope[nt] * (float)dist : NEGF;
          s[kt2][nt][r] = sv;
          mx = fmaxf(mx, sv);
        }
      mx = fmaxf(mx, __shfl_xor(mx, 16));
      mx = fmaxf(mx, __shfl_xor(mx, 32));
      const float mnew = fmaxf(m[nt], mx);
      float ps = 0.f;
#pragma unroll
      for (int kt2 = 0; kt2 < 2; ++kt2)
#pragma unroll
        for (int r = 0; r < 4; ++r) {
          float sv = s[kt2][nt][r];
          ps += (sv > -5e29f) ? ex2(sv - mnew) : 0.f;
        }
      l[nt] = l[nt] * ex2(m[nt] - mnew) + ps;
      m[nt] = mnew;
    }
  }
  float invl[4];
#pragma unroll
  for (int nt = 0; nt < 4; ++nt) {
    float lt = quad_sum(l[nt]);
    invl[nt] = lt > 0.f ? 1.f / lt : 0.f;
  }
  float2* xy = (float2*)smem + wave * (16 * 65);
  __syncthreads();
  for (int j = steps * 8 + quad; j < 64; j += 4) xy[l15 * 65 + j] = (float2){0.f, 0.f};
  zero_acc(o);
  for (int st = 0; st < steps; ++st) {
    bf16x8 kf[2][2];
#pragma unroll
    for (int kt2 = 0; kt2 < 2; ++kt2) {
      const u16* kp = KC + (size_t)(st * 32 + kt2 * 16 + l15) * 64 + quad * 8;
      kf[kt2][0] = *(const bf16x8*)(kp);
      kf[kt2][1] = *(const bf16x8*)(kp + 32);
    }
    bf16x8 pf[4];
    float psum[8];
#pragma unroll
    for (int i = 0; i < 8; ++i) psum[i] = 0.f;
#pragma unroll
    for (int nt = 0; nt < 4; ++nt) {
      f32x4 s0 = (f32x4){0.f, 0.f, 0.f, 0.f}, s1 = s0;
      const bf16x8 q0 = qf.get(nt, 0), q1 = qf.get(nt, 1);
      s0 = MFMA16(kf[0][0], q0, s0);
      s0 = MFMA16(kf[0][1], q1, s0);
      s1 = MFMA16(kf[1][0], q0, s1);
      s1 = MFMA16(kf[1][1], q1, s1);
      float pv[8];
#pragma unroll
      for (int kt2 = 0; kt2 < 2; ++kt2)
#pragma unroll
        for (int r = 0; r < 4; ++r) {
          const int c = st * 32 + kt2 * 16 + quad * 4 + r;
          const int dist = tok - (16 * c + 31);
          float sv = (kt2 ? s1[r] : s0[r]) - slope[nt] * (float)dist;
          float e = (dist >= 0) ? ex2(sv - m[nt]) * invl[nt] : 0.f;
          pv[kt2 * 4 + r] = e;
          psum[kt2 * 4 + r] += e;
        }
      pf[nt] = pack8(pv);
    }
#pragma unroll
    for (int kt2 = 0; kt2 < 2; ++kt2) {
      float X = psum[kt2 * 4], Y = X + 2.f * (psum[kt2 * 4 + 1] + psum[kt2 * 4 + 2] + psum[kt2 * 4 + 3]);
      xy[l15 * 65 + (st * 2 + kt2) * 4 + quad] = (float2){X, Y};
    }
    pv_step(pf, VCT + st * 32, 256, lane, o);
  }
#pragma unroll
  for (int nt = 0; nt < 4; ++nt) gate[nt] = bf2f(GN[grow * 32 + 0 * 8 + g * 4 + nt]);
  tot_store(TOT, grow, g, quad, o, gate, false);
  __syncthreads();
  unsigned mlo = 0u, mhi = 0u;
  if (lane < 16) {
    const int tp = t0 + lane, cur = tp >> 6;
    float* sc = (float*)(xy + lane * 65);
    float prevY = 0.f;
    for (int jb = 0; jb < 64; ++jb) {
      float2 v = xy[lane * 65 + jb];
      float imp = v.x + prevY;
      prevY = v.y;
      const bool causal = jb <= cur;
      const bool forced = (jb == 0) | (jb == cur) | (jb == cur - 1);
      sc[jb] = causal ? (forced ? 1e30f : imp) : -1e30f;
    }
    for (int it = 0; it < 16; ++it) {
      float best = -3.0e38f;
      int bi = 0;
      for (int jb = 0; jb < 64; ++jb) {
        float v = sc[jb];
        if (v > best) { best = v; bi = jb; }
      }
      sc[bi] = -3.4e38f;
      if (bi <= cur) {
        if (bi < 32) mlo |= 1u << bi; else mhi |= 1u << (bi - 32);
      }
    }
  }
  mlo = __shfl(mlo, l15);
  mhi = __shfl(mhi, l15);

  {
    init_state(m, l, o);
    const u16* vt = (const u16*)(p.ws + OFF_VTS) + (size_t)bg * 64 * 4096;
    unsigned ulo = mlo, uhi = mhi;
#pragma unroll
    for (int sh = 1; sh < 16; sh <<= 1) { ulo |= __shfl_xor(ulo, sh); uhi |= __shfl_xor(uhi, sh); }
    ulo = __builtin_amdgcn_readfirstlane(ulo);
    uhi = __builtin_amdgcn_readfirstlane(uhi);
    unsigned long long um = ((unsigned long long)uhi << 32) | ulo;
    int pend = -1;
    const u16* kbase = (const u16*)(p.ws + OFF_KS) + (size_t)bg * 4096 * 64;
    attn_pipeline(
        [&]() {
          if (pend >= 0) { int k = pend; pend = -1; return k; }
          if (um == 0ull) return -1;
          const int jb = __builtin_ctzll(um);
          um &= um - 1ull;
          const int k = jb * 64;
          if (k + 32 <= t0 + 15) pend = k + 32;
          return k;
        },
        [&](KV& kv, int key0) { load_kv(kv, kbase + (size_t)key0 * 64, 64, vt + (size_t)key0 * 64, 32, lane); },
        [&](const KV& kv, int key0) {
          const int jb = key0 >> 6;
          const bool mine = (jb < 32) ? ((mlo >> jb) & 1u) : ((mhi >> (jb - 32)) & 1u);
          attn_compute(qf, kv, 32, slope, m, l, o, __all(mine) && (key0 + 31 <= t0),
                       [&](int kt2, int r, float& fd, bool& valid) {
                         const int dist = tok - (key0 + kt2 * 16 + quad * 4 + r);
                         valid = mine && (dist >= 0);
                         fd = (float)dist;
                       });
        });
    float scl[4];
#pragma unroll
    for (int nt = 0; nt < 4; ++nt) {
      float lt = quad_sum(l[nt]);
      scl[nt] = lt > 0.f ? bf2f(GN[grow * 32 + 1 * 8 + g * 4 + nt]) / lt : 0.f;
    }
    tot_store(TOT, grow, g, quad, o, scl, true);
  }
  {
    init_state(m, l, o);
    const u16* vt = (const u16*)(p.ws + OFF_VTW) + (size_t)bg * 64 * 4096;
    banded_attn<512>(qf, (const u16*)(p.ws + OFF_KW) + (size_t)bg * 4096 * 64, t0, vt, lane, slope, m, l, o);
    u16* OA = (u16*)(p.ws + OFF_H);
#pragma unroll
    for (int nt = 0; nt < 4; ++nt) {
      float lt = quad_sum(l[nt]);
      const float scw = lt > 0.f ? bf2f(GN[grow * 32 + 2 * 8 + g * 4 + nt]) / lt : 0.f;
#pragma unroll
      for (int dt = 0; dt < 4; ++dt) {
        const int col = (g * 4 + nt) * 64 + dt * 16 + quad * 4;
        f32x4 tv = *(const f32x4*)(TOT + grow * 512 + col) + o[dt][nt] * scw;
        u32x2 z = *(const u32x2*)(P + grow * LDP + C_ZA + col);
        u32x2 ov = {pack2(tv[0] * bflo(z.x), tv[1] * bfhi(z.x)), pack2(tv[2] * bflo(z.y), tv[3] * bfhi(z.y))};
        *(u32x2*)(OA + grow * 512 + col) = ov;
      }
    }
  }
}

__device__ void swa_item(const Params& p, int item, char* smem) {
  const u16* P = (const u16*)(p.ws + OFF_P);
  const int t = threadIdx.x, lane = t & 63, wave = t >> 6, quad = lane >> 4, l15 = lane & 15;
  const int bg = item >> 5, tb0 = (item & 31) * 128;
  const int b = bg >> 1, g = bg & 1;
  const int t0 = tb0 + wave * 16, tok = t0 + l15;
  const size_t grow = (size_t)(b * 4096 + tok);
  QF qf;
  load_q(qf, smem + 66560 + wave * 8192, P, b * 4096 + t0, C_QB + g * 256, lane);
  float slope[4];
#pragma unroll
  for (int nt = 0; nt < 4; ++nt) slope[nt] = exp2f(-(float)(g * 4 + nt + 1)) * 1.44269504f;
  float m[4], l[4];
  f32x4 o[4][4];
  init_state(m, l, o);
  const u16* vt = (const u16*)(p.ws + OFF_VTB) + (size_t)bg * 64 * 4096;
  banded_attn<128>(qf, (const u16*)(p.ws + OFF_KB) + (size_t)bg * 4096 * 64, t0, vt, lane, slope, m, l, o);
  u16* OB = (u16*)(p.ws + OFF_H) + (size_t)T_TOK * 512;
#pragma unroll
  for (int nt = 0; nt < 4; ++nt) {
    float lt = quad_sum(l[nt]) + ex2(p.sinks[g * 4 + nt] * 1.44269504f - m[nt]);
    float inv = 1.f / lt;
#pragma unroll
    for (int dt = 0; dt < 4; ++dt) {
      const int col = (g * 4 + nt) * 64 + dt * 16 + quad * 4;
      u32x2 z = *(const u32x2*)(P + grow * LDP + C_ZB + col);
      u32x2 ov = {pack2(o[dt][nt][0] * inv * bflo(z.x), o[dt][nt][1] * inv * bfhi(z.x)),
                  pack2(o[dt][nt][2] * inv * bflo(z.y), o[dt][nt][3] * inv * bfhi(z.y))};
      *(u32x2*)(OB + grow * 512 + col) = ov;
    }
  }
}

__device__ void phase4(const Params& p, char* smem) {
  for (int item = blockIdx.x; item < 512; item += gridDim.x) {
    if (item < 256) nsa_item(p, 255 - item, smem);
    else swa_item(p, item - 256, smem);
  }
}

DI int tiles5_count() {
  if (gridDim.x != 256) return ((int)blockIdx.x < 256) ? (255 - (int)blockIdx.x) / (int)gridDim.x + 1 : 0;
  return 1;
}
DI int tiles5_of(int j) {
  if (gridDim.x != 256) return blockIdx.x + j * gridDim.x;
  const int x = blockIdx.x & 7, s = blockIdx.x >> 3;
  return (8 * x + (s & 7)) * 4 + (s >> 3);
}
struct Geom5a {
  const u16 *OA, *OB, *WA, *WB;
  DI int count() const { return tiles5_count(); }
  DI int tile_of(int j) const { return tiles5_of(j); }
  DI void ptrs(int tile, int kt, const u16*& a, int& lda, const u16*& b, int& ldb) const {
    const int m0 = (tile >> 2) * 256, n0 = (tile & 3) * 256;
    lda = 512; ldb = 512;
    if (kt < 16) { a = OA + (size_t)m0 * 512 + kt * 32; b = WA + (size_t)n0 * 512 + kt * 32; }
    else { a = OB + (size_t)m0 * 512 + (kt - 16) * 32; b = WB + (size_t)n0 * 512 + (kt - 16) * 32; }
  }
};
__device__ void phase5a(const Params& p, char* smem) {
  const u16* OA = (const u16*)(p.ws + OFF_H);
  Geom5a geom{OA, OA + (size_t)T_TOK * 512, (const u16*)(p.ws + OFF_WTOA), (const u16*)(p.ws + OFF_WTOB)};
  const u16* P = (const u16*)(p.ws + OFF_P);
  u16* U = (u16*)(p.ws + OFF_U);
  const int t = threadIdx.x, lane = t & 63, wave = t >> 6, wm = wave >> 2, wn = wave & 3, quad_ = lane >> 4,
            l15_ = lane & 15;
  auto mid = [&](int tile, f32x4 (&acc)[8][4]) {
    int l15 = l15_, quad = quad_;
    asm volatile("" : "+v"(l15), "+v"(quad));
    const int m0 = (tile >> 2) * 256, n0 = (tile & 3) * 256;
#pragma unroll
    for (int i = 0; i < 8; ++i)
#pragma unroll
      for (int j = 0; j < 4; ++j) {
        const int tok = m0 + wm * 128 + i * 16 + l15;
        const int n = n0 + wn * 64 + j * 16 + quad * 4;
        u32x2 ga = *(const u32x2*)(P + (size_t)tok * LDP + C_MA + n);
        u32x2 gb = *(const u32x2*)(P + (size_t)tok * LDP + C_MB + n);
        acc[i][j][0] *= bflo(ga.x) * __builtin_amdgcn_rcpf(bflo(gb.x));
        acc[i][j][1] *= bfhi(ga.x) * __builtin_amdgcn_rcpf(bfhi(gb.x));
        acc[i][j][2] *= bflo(ga.y) * __builtin_amdgcn_rcpf(bflo(gb.y));
        acc[i][j][3] *= bfhi(ga.y) * __builtin_amdgcn_rcpf(bfhi(gb.y));
        if (j == 3) __builtin_amdgcn_sched_barrier(0);
      }
  };
  auto epi = [&](int tile, f32x4 (&acc)[8][4]) {
    int l15 = l15_, quad = quad_;
    asm volatile("" : "+v"(l15), "+v"(quad));
    const int m0 = (tile >> 2) * 256, n0 = (tile & 3) * 256;
#pragma unroll
    for (int i = 0; i < 8; ++i)
#pragma unroll
      for (int j = 0; j < 4; ++j) {
        const int tok = m0 + wm * 128 + i * 16 + l15;
        const int n = n0 + wn * 64 + j * 16 + quad * 4;
        u32x2 gb = *(const u32x2*)(P + (size_t)tok * LDP + C_MB + n);
        u32x2 ov = {pack2(acc[i][j][0] * bflo(gb.x), acc[i][j][1] * bfhi(gb.x)),
                    pack2(acc[i][j][2] * bflo(gb.y), acc[i][j][3] * bfhi(gb.y))};
        *(u32x2*)(U + (size_t)tok * 1024 + n) = ov;
        if (j == 3) __builtin_amdgcn_sched_barrier(0);
      }
  };
  gemm_stream<true>(geom, mid, epi, smem);
}

struct Geom5b {
  const u16 *U, *W;
  DI int count() const { return tiles5_count(); }
  DI int tile_of(int j) const { return tiles5_of(j); }
  DI void ptrs(int tile, int kt, const u16*& a, int& lda, const u16*& b, int& ldb) const {
    const int m0 = (tile >> 2) * 256, n0 = (tile & 3) * 256;
    lda = 1024; ldb = 1024;
    a = U + (size_t)m0 * 1024 + kt * 32;
    b = W + (size_t)n0 * 1024 + kt * 32;
  }
};
__device__ void phase5b(const Params& p, char* smem) {
  Geom5b geom{(const u16*)(p.ws + OFF_U), (const u16*)(p.ws + OFF_WTOUT)};
  u16* Y = (u16*)(p.ws + OFF_P);
  const int t = threadIdx.x, lane = t & 63, wave = t >> 6, wm = wave >> 2, wn = wave & 3, quad_ = lane >> 4,
            l15_ = lane & 15;
  auto epi = [&](int tile, f32x4 (&acc)[8][4]) {
    int l15 = l15_, quad = quad_;
    asm volatile("" : "+v"(l15), "+v"(quad));
    const int m0 = (tile >> 2) * 256, n0 = (tile & 3) * 256;
#pragma unroll
    for (int i = 0; i < 8; ++i)
#pragma unroll
      for (int j = 0; j < 4; ++j) {
        const int tok = m0 + wm * 128 + i * 16 + l15;
        const int n = n0 + wn * 64 + j * 16 + quad * 4;
        u32x2 ov = {pack2(acc[i][j][0], acc[i][j][1]), pack2(acc[i][j][2], acc[i][j][3])};
        *(u32x2*)(Y + (size_t)tok * 1024 + n) = ov;
      }
  };
  auto nomid = [](int, f32x4 (&)[8][4]) {};
  gemm_stream<false>(geom, nomid, epi, smem);
}

__device__ void phase5c(const Params& p, char* smem) {
  const int t = threadIdx.x, lane = t & 63, wave = t >> 6;
  float* gg = (float*)smem;
  const u16* Y = (const u16*)(p.ws + OFF_P);
  for (int row0 = blockIdx.x * 64; row0 < T_TOK; row0 += gridDim.x * 64) {
    const int b = row0 >> 12;
    __syncthreads();
    for (int c = t; c < 1024; c += 512) gg[c] = p.g_post[c] * mod_value(p, b, 2048 + c);
    __syncthreads();
#pragma unroll 2
    for (int rr = 0; rr < 8; ++rr) {
      const int row = row0 + wave * 8 + rr;
      const u32x4* yr = (const u32x4*)(Y + (size_t)row * 1024);
      const float4* xr = (const float4*)(p.x + (size_t)row * 1024);
      float v[16];
      float ss = 0.f;
#pragma unroll
      for (int i = 0; i < 2; ++i) {
        u32x4 u = yr[lane + 64 * i];
        v[i * 8 + 0] = bflo(u.x); v[i * 8 + 1] = bfhi(u.x); v[i * 8 + 2] = bflo(u.y); v[i * 8 + 3] = bfhi(u.y);
        v[i * 8 + 4] = bflo(u.z); v[i * 8 + 5] = bfhi(u.z); v[i * 8 + 6] = bflo(u.w); v[i * 8 + 7] = bfhi(u.w);
      }
#pragma unroll
      for (int i = 0; i < 16; ++i) ss += v[i] * v[i];
      ss = wave_sum(ss);
      const float rstd = rsqrtf(ss * (1.f / 1024.f) + 1e-6f);
#pragma unroll
      for (int i = 0; i < 2; ++i)
#pragma unroll
        for (int hh = 0; hh < 2; ++hh) {
          const int c4 = (lane + 64 * i) * 2 + hh;
          float4 g = ((const float4*)gg)[c4];
          float4 xv = xr[c4];
          float4 o;
          o.x = xv.x + g.x * (v[i * 8 + hh * 4 + 0] * rstd);
          o.y = xv.y + g.y * (v[i * 8 + hh * 4 + 1] * rstd);
          o.z = xv.z + g.z * (v[i * 8 + hh * 4 + 2] * rstd);
          o.w = xv.w + g.w * (v[i * 8 + hh * 4 + 3] * rstd);
          ((float4*)(p.out + (size_t)row * 1024))[c4] = o;
        }
    }
  }
}
DI void grid_barrier(unsigned* counter, unsigned target) {
  asm volatile("s_waitcnt vmcnt(0) lgkmcnt(0)" ::: "memory");
  __syncthreads();
  if (threadIdx.x == 0) {
    __threadfence();
    asm volatile("s_waitcnt vmcnt(0)" ::: "memory");
    __hip_atomic_fetch_add(counter, 1u, __ATOMIC_RELAXED, __HIP_MEMORY_SCOPE_AGENT);
    while (__hip_atomic_load(counter, __ATOMIC_RELAXED, __HIP_MEMORY_SCOPE_AGENT) < target) __builtin_amdgcn_s_sleep(2);
    __threadfence();
  }
  __syncthreads();
}

extern __shared__ __attribute__((aligned(16))) char smem[];
__global__ void __launch_bounds__(512) mk(Params p) {
  cg::grid_group grid = cg::this_grid();
  unsigned* bar = (unsigned*)(p.ws + OFF_BAR);
  const unsigned nb = gridDim.x;
  phase0(p, smem);
  grid.sync();
  phase1(p, smem);
  grid_barrier(bar, nb);
  phase2(p, smem);
  grid_barrier(bar, 2 * nb);
  phase3(p, smem);
  grid_barrier(bar, 3 * nb);
  phase4(p, smem);
  grid_barrier(bar, 4 * nb);
  phase5a(p, smem);
  grid_barrier(bar, 5 * nb);
  phase5b(p, smem);
  grid_barrier(bar, 6 * nb);
  phase5c(p, smem);
}

extern "C" void kernel_launch(void* const* d_in, const int* in_sizes, int n_in, void* d_out, int out_size,
                              void* d_ws, size_t ws_size, hipStream_t stream) {
  static int grid_blocks = 0;
  if (!grid_blocks) {
    int dev = 0, cus = 0, per_cu = 0;
    (void)hipGetDevice(&dev);
    (void)hipDeviceGetAttribute(&cus, hipDeviceAttributeMultiprocessorCount, dev);
    (void)hipFuncSetAttribute((const void*)mk, hipFuncAttributeMaxDynamicSharedMemorySize, SMEM_BYTES);
    (void)hipOccupancyMaxActiveBlocksPerMultiprocessor(&per_cu, mk, 512, SMEM_BYTES);
    if (per_cu > 1) per_cu = 1;
    if (per_cu < 1) per_cu = 1;
    grid_blocks = cus * per_cu;
  }
  if (ws_size < WS_NEED) fprintf(stderr, "workspace too small: %zu < %zu\n", ws_size, (size_t)WS_NEED);
  Params p{};
  const float* const* in = (const float* const*)d_in;
  p.x = in[0]; p.c = in[1]; p.w_ada = in[2]; p.b_ada = in[3]; p.g_pre = in[4]; p.g_post = in[5]; p.w_in = in[6];
  p.pe_k = in[7]; p.pe_v = in[8]; p.w1k = in[9]; p.w2k = in[10]; p.w1v = in[11]; p.w2v = in[12];
  p.w_o_nsa = in[13]; p.w_o_swa = in[14]; p.w_out = in[15]; p.sinks = in[16];
  p.out = (float*)d_out;
  p.ws = (char*)d_ws;
  (void)hipMemsetAsync((char*)d_ws + OFF_BAR, 0, 256, stream);
  void* args[] = {&p};
  hipError_t e = hipLaunchCooperativeKernel((void*)mk, dim3(grid_blocks), dim3(512), args, SMEM_BYTES, stream);
  if (e != hipSuccess) fprintf(stderr, "cooperative launch failed: %s (grid %d)\n", hipGetErrorString(e), grid_blocks);
}
```

```cpp
#include <hip/hip_runtime.h>
#include <hip/hip_cooperative_groups.h>
#include <cstdio>
namespace cg = cooperative_groups;

typedef unsigned short u16;
using bf16x8 = __attribute__((ext_vector_type(8))) short;
using bf16x4 = __attribute__((ext_vector_type(4))) short;
using f32x4 = __attribute__((ext_vector_type(4))) float;
using u32x4 = __attribute__((ext_vector_type(4))) unsigned;
using u32x2 = __attribute__((ext_vector_type(2))) unsigned;
typedef __bf16 bf16x2_t __attribute__((ext_vector_type(2)));
typedef float f32x2_t __attribute__((ext_vector_type(2)));

#define DI __device__ __forceinline__
#define MFMA16(a, b, c) __builtin_amdgcn_mfma_f32_16x16x32_bf16((a), (b), (c), 0, 0, 0)

constexpr int T_TOK = 16384, SEQ = 4096, DM = 1024, LDP = 4160, NIN = 5248;
constexpr float NEGF = -1e30f;
constexpr int C_QA = 0, C_ZA = 512, C_QB = 1024, C_ZB = 1536, C_MA = 2048, C_MB = 3072;

constexpr size_t OFF_P = 0;
constexpr size_t OFF_H = OFF_P + (size_t)T_TOK * LDP * 2;
constexpr size_t OFF_U = OFF_H + 33554432;
constexpr size_t OFF_VTS = OFF_U + 33554432;
constexpr size_t OFF_VTW = OFF_VTS + 4194304;
constexpr size_t OFF_VTB = OFF_VTW + 4194304;
constexpr size_t OFF_KS = OFF_VTB + 4194304;
constexpr size_t OFF_KW = OFF_KS + 4194304;
constexpr size_t OFF_KB = OFF_KW + 4194304;
constexpr size_t OFF_KCR = OFF_KB + 4194304;
constexpr size_t OFF_WTIN = OFF_KCR + 8388608;
constexpr size_t OFF_WTOA = OFF_WTIN + (size_t)NIN * 1024 * 2;
constexpr size_t OFF_WTOB = OFF_WTOA + 1048576;
constexpr size_t OFF_WTOUT = OFF_WTOB + 1048576;
constexpr size_t OFF_WT1K = OFF_WTOUT + 2097152;
constexpr size_t OFF_WT1V = OFF_WT1K + 1048576;
constexpr size_t OFF_WT2K = OFF_WT1V + 1048576;
constexpr size_t OFF_WT2V = OFF_WT2K + 32768;
constexpr size_t OFF_KC = OFF_WT2V + 32768;
constexpr size_t OFF_VCT = OFF_KC + 262144;
constexpr size_t OFF_GN = OFF_VCT + 262144;
constexpr size_t OFF_MOD = OFF_GN + 1048576;
constexpr size_t OFF_BIAS1 = OFF_MOD + 49152;
constexpr size_t OFF_BAR = OFF_BIAS1 + 2048;
constexpr size_t OFF_MODP = OFF_BAR + 256;
constexpr size_t OFF_BIASP = OFF_MODP + 8 * 4 * 3072 * 4;
constexpr size_t WS_NEED = OFF_BIASP + 2 * 32 * 256 * 4;
static_assert(WS_NEED <= 268435456, "workspace layout exceeds 256 MiB");

struct Params {
  const float *x, *c, *w_ada, *b_ada, *g_pre, *g_post, *w_in, *pe_k, *pe_v, *w1k, *w2k, *w1v, *w2v,
      *w_o_nsa, *w_o_swa, *w_out, *sinks;
  float* out;
  char* ws;
};

DI unsigned pack2(float a, float b) {
  f32x2_t v = {a, b};
  bf16x2_t r = __builtin_convertvector(v, bf16x2_t);
  return __builtin_bit_cast(unsigned, r);
}
DI float bf2f(u16 h) { return __uint_as_float(((unsigned)h) << 16); }
DI float bflo(unsigned u) { return __uint_as_float(u << 16); }
DI float bfhi(unsigned u) { return __uint_as_float(u & 0xffff0000u); }
DI float sigmoidf_(float x) { return __builtin_amdgcn_rcpf(1.f + __expf(-x)); }
DI float siluf_(float x) { return x * __builtin_amdgcn_rcpf(1.f + __expf(-x)); }
DI float wave_sum(float v) {
#pragma unroll
  for (int o = 32; o >= 1; o >>= 1) v += __shfl_xor(v, o);
  return v;
}
DI int map_col(int n, int mode) {
  if (mode == 0) return n;
  if (n < 1280) return n;
  if (n < 5120) return n + 24;
  if (n < 5144) return 1280 + (n - 5120);
  return -1;
}
struct TDesc { const float* src; u16* dst; int K, N, kt, nt, mode; };

template <int PART>
__device__ void phase0(const Params& p, char* smem) {
  const int half = threadIdx.x >> 8, t = threadIdx.x & 255;
  float* fs = (float*)smem + half * 4352;
  constexpr int N_IN = 16 * 82, N_OA = 8 * 16, N_OUT = 16 * 16, N_1 = 32 * 4, N_2 = 4, N_ADA = 384, N_B = 64;
  constexpr int E0 = N_IN, E1 = E0 + N_OA, E2 = E1 + N_OA, E3 = E2 + N_OUT, E4 = E3 + N_1, E5 = E4 + N_1,
                E6 = E5 + N_2, E7 = E6 + N_2, E8 = E7 + N_ADA, E9 = E8 + N_B;
  const int stride = gridDim.x * 2;
  constexpr int LO = (PART == 0) ? E7 : 0, HI = (PART == 0) ? E9 : E7;
  const int rounds = (HI - LO + stride - 1) / stride;
  __syncthreads();
  for (int it = 0; it < rounds; ++it) {
    const int item = LO + it * stride + blockIdx.x * 2 + half;
    int kind = 3;
    TDesc d{};
    if (PART == 1 && item < E7) {
      kind = 0;
      if (item < E0) d = TDesc{p.w_in, (u16*)(p.ws + OFF_WTIN), 1024, 5144, item / 82, item % 82, 1};
      else if (item < E1) { int i = item - E0; d = TDesc{p.w_o_nsa, (u16*)(p.ws + OFF_WTOA), 512, 1024, i / 16, i % 16, 0}; }
      else if (item < E2) { int i = item - E1; d = TDesc{p.w_o_swa, (u16*)(p.ws + OFF_WTOB), 512, 1024, i / 16, i % 16, 0}; }
      else if (item < E3) { int i = item - E2; d = TDesc{p.w_out, (u16*)(p.ws + OFF_WTOUT), 1024, 1024, i / 16, i % 16, 0}; }
      else if (item < E4) { int i = item - E3; d = TDesc{p.w1k, (u16*)(p.ws + OFF_WT1K), 2048, 256, i / 4, i % 4, 0}; }
      else if (item < E5) { int i = item - E4; d = TDesc{p.w1v, (u16*)(p.ws + OFF_WT1V), 2048, 256, i / 4, i % 4, 0}; }
      else if (item < E6) { int i = item - E5; d = TDesc{p.w2k, (u16*)(p.ws + OFF_WT2K), 256, 64, i, 0, 0}; }
      else { int i = item - E6; d = TDesc{p.w2v, (u16*)(p.ws + OFF_WT2V), 256, 64, i, 0, 0}; }
    } else if (PART == 0 && item < E8) kind = 1;
    else if (PART == 0 && item < E9) kind = 2;

    if (kind == 0) {
      const int tx = t & 63, ty = t >> 6;
      const int k0 = d.kt * 64, n0 = d.nt * 64;
      const int sc = map_col(n0 + tx, d.mode);
#pragma unroll
      for (int i = 0; i < 16; ++i) {
        int k = ty + 4 * i;
        fs[k * 65 + tx] = (sc >= 0) ? d.src[(size_t)(k0 + k) * d.N + sc] : 0.f;
      }
    } else if (kind == 1) {
      const int ai = item - E7, q = ai / 48;
      int n0 = (ai % 48) * 64, col = t & 63, kg = t >> 6;
      float a0 = 0.f, a1 = 0.f, a2 = 0.f, a3 = 0.f;
#pragma unroll 8
      for (int i = 0; i < 32; ++i) {
        const int k = q * 128 + kg + 4 * i;
        float w = p.w_ada[(size_t)k * 3072 + n0 + col];
        a0 += p.c[k] * w; a1 += p.c[1024 + k] * w; a2 += p.c[2048 + k] * w; a3 += p.c[3072 + k] * w;
      }
      fs[(kg * 4 + 0) * 64 + col] = a0; fs[(kg * 4 + 1) * 64 + col] = a1;
      fs[(kg * 4 + 2) * 64 + col] = a2; fs[(kg * 4 + 3) * 64 + col] = a3;
    }
    __syncthreads();
    if (kind == 0) {
      const int k0 = d.kt * 64, n0 = d.nt * 64;
      const int c2 = t & 31, r = t >> 5;
#pragma unroll
      for (int i = 0; i < 8; ++i) {
        int rr = r + 8 * i;
        unsigned v = pack2(fs[(2 * c2) * 65 + rr], fs[(2 * c2 + 1) * 65 + rr]);
        *(unsigned*)(d.dst + (size_t)(n0 + rr) * d.K + k0 + 2 * c2) = v;
      }
    } else if (kind == 1) {
      const int ai = item - E7, q = ai / 48;
      int n0 = (ai % 48) * 64, col = t & 63, b = t >> 6;
      float s = fs[(0 * 4 + b) * 64 + col] + fs[(1 * 4 + b) * 64 + col] + fs[(2 * 4 + b) * 64 + col] +
                fs[(3 * 4 + b) * 64 + col];
      ((float*)(p.ws + OFF_MODP))[(q * 4 + b) * 3072 + n0 + col] = s;
    } else if (kind == 2) {
      const int bi = item - E8, kv = bi >> 5, kc = bi & 31;
      const float* pe = (kv ? p.pe_v : p.pe_k) + kc * 64;
      const float* w1 = (kv ? p.w1v : p.w1k) + (size_t)kc * 64 * 256;
      float a = 0.f;
#pragma unroll 16
      for (int k = 0; k < 64; ++k) a += pe[k] * w1[(size_t)k * 256 + t];
      ((float*)(p.ws + OFF_BIASP))[(kv * 32 + kc) * 256 + t] = a;
    }
    __syncthreads();
  }
}

DI float mod_value(const Params& p, int b, int idx) {
  const float* mp = (const float*)(p.ws + OFF_MODP) + b * 3072 + idx;
  float s = p.b_ada[idx];
#pragma unroll
  for (int q = 0; q < 8; ++q) s += mp[q * 4 * 3072];
  return s;
}
__device__ void phase1(const Params& p, char* smem) {
  const int t = threadIdx.x, lane = t & 63, wave = t >> 6;
  float* gs = (float*)smem;
  float* sh = gs + 1024;
  u16* H = (u16*)(p.ws + OFF_H);
  for (int row0 = blockIdx.x * 64; row0 < T_TOK; row0 += gridDim.x * 64) {
    const int b = row0 >> 12;
    __syncthreads();
    for (int c = t; c < 1024; c += 512) {
      sh[c] = mod_value(p, b, c);
      gs[c] = p.g_pre[c] * (1.f + mod_value(p, b, 1024 + c));
    }
    __syncthreads();
#pragma unroll 2
    for (int rr = 0; rr < 8; ++rr) {
      const int row = row0 + wave * 8 + rr;
      const float4* xr = (const float4*)(p.x + (size_t)row * 1024);
      float4 v[4];
      float ss = 0.f;
#pragma unroll
      for (int i = 0; i < 4; ++i) {
        v[i] = xr[lane + 64 * i];
        ss += v[i].x * v[i].x + v[i].y * v[i].y + v[i].z * v[i].z + v[i].w * v[i].w;
      }
      ss = wave_sum(ss);
      const float rstd = rsqrtf(ss * (1.f / 1024.f) + 1e-6f);
#pragma unroll
      for (int i = 0; i < 4; ++i) {
        const int cidx = lane + 64 * i;
        float4 g = ((const float4*)gs)[cidx];
        float4 s4 = ((const float4*)sh)[cidx];
        float h0 = v[i].x * rstd * g.x + s4.x;
        float h1 = v[i].y * rstd * g.y + s4.y;
        float h2 = v[i].z * rstd * g.z + s4.z;
        float h3 = v[i].w * rstd * g.w + s4.w;
        u32x2 o = {pack2(h0, h1), pack2(h2, h3)};
        *(u32x2*)(H + (size_t)row * 1024 + cidx * 4) = o;
      }
    }
  }
}
constexpr int SMEM_BYTES = 139264;
DI void zero_acc(f32x4 (&acc)[4][4]) {
#pragma unroll
  for (int i = 0; i < 4; ++i)
#pragma unroll
    for (int j = 0; j < 4; ++j) acc[i][j] = (f32x4){0.f, 0.f, 0.f, 0.f};
}
namespace pg8 {
#define PG8_LAS __attribute__((address_space(3)))
constexpr int BM = 256, BK = 64, HALF = 128, HTB = HALF * BK * 2, NXCD = 8, WGM = 8;
DI int lds_byte(int r, int c) { const int st = (r >> 4) * 2 + (c >> 5), rr = r & 15, cc = c & 31, ob = rr * 64 + cc * 2; return st * 1024 + (ob ^ (((ob >> 9) & 1) << 5)); }
DI void stage_rc(int b, int& R, int& C) { const int st = b / 1024, sb = b % 1024, swz = sb ^ (((sb >> 9) & 1) << 5); R = (st >> 1) * 16 + swz / 64; C = (st & 1) * 32 + (swz % 64) / 2; }
struct Unit { int pm, pn; };
struct Gemm { const u16* A; const u16* Bt; const u16* A2; const u16* Bt2; int M, N, K; };
struct StaticOrder {
  int nM, nN, nwg, G, c;
  DI void init(int M, int N, int G_, int c_) { nM = M / BM; nN = N / BM; nwg = nM * nN; G = G_; c = c_; }
  DI bool next(int i, Unit& u) const {
    const long L = (long)i * G + c; if (L >= nwg) return false;
    int wgid = (int)L; { const int q = nwg / NXCD, r = nwg % NXCD, xcd = wgid % NXCD, off = wgid / NXCD; wgid = (xcd < r ? xcd * (q + 1) : r * (q + 1) + (xcd - r) * q) + off; }
    const int nig = WGM * nN, gid = wgid / nig, fm = gid * WGM, gsz = (nM - fm) < WGM ? (nM - fm) : WGM;
    u.pm = fm + ((wgid % nig) % gsz); u.pn = (wgid % nig) / gsz; return true;
  }
};

template <class Epi>
DI void gemm_phase(PG8_LAS unsigned char* lds, const Gemm g, const StaticOrder& S, const Epi& E) {
  const int tid = threadIdx.x, wid = __builtin_amdgcn_readfirstlane(tid >> 6), lane = tid & 63, wr = wid >> 2, wc = wid & 3, fr = lane & 15, fq = lane >> 4;
  const int K = g.K, ntH = K / BK, nt = g.A2 ? 2 * ntH : ntH;
  unsigned voffA[2], voffB[2];
#pragma unroll
  for (int i = 0; i < 2; ++i) { int R, C; stage_rc(tid * 16 + i * 8192, R, C); voffA[i] = (unsigned)(R * K + C) * 2u; voffB[i] = voffA[i]; }
  const size_t kstep = (size_t)(BK * 2);
  const size_t hstep = (size_t)HALF * K * 2;
  const size_t tstep = 2 * hstep;
  const unsigned ldsw = (unsigned)wid * 1024u;
  const int aoff = lds_byte(wr * 64 + fr, fq * 8), boff = lds_byte(wc * 32 + fr, fq * 8);
#define PG8_SA(b, h) (((b) * 2 + (h)) * HTB)
#define PG8_SB(b, h) ((4 + (b) * 2 + (h)) * HTB)
#define PG8_STAGE(bufoff, gbase, voff) do { _Pragma("unroll") for (int _i = 0; _i < 2; ++_i) \
    __builtin_amdgcn_global_load_lds((const unsigned*)((const char*)(gbase) + (voff)[_i]), (PG8_LAS unsigned*)(lds + (bufoff) + ldsw + _i * 8192), 16, 0, 0); } while (0)
#define PG8_LDA(dst, b, h) do { _Pragma("unroll") for (int m = 0; m < 4; ++m) _Pragma("unroll") for (int k = 0; k < 2; ++k) dst[m][k] = *(const PG8_LAS bf16x8*)(lds + PG8_SA(b, h) + aoff + m * 2048 + k * 1024); } while (0)
#define PG8_LDB(dst, b, h) do { _Pragma("unroll") for (int n = 0; n < 2; ++n) _Pragma("unroll") for (int k = 0; k < 2; ++k) dst[n][k] = *(const PG8_LAS bf16x8*)(lds + PG8_SB(b, h) + boff + n * 2048 + k * 1024); } while (0)
#define PG8_MMA(ai, bj, At, Bt) do { __builtin_amdgcn_s_setprio(1); _Pragma("unroll") for (int m = 0; m < 4; ++m) _Pragma("unroll") for (int n = 0; n < 2; ++n) _Pragma("unroll") for (int k = 0; k < 2; ++k) \
    acc[ai][bj][m][n] = __builtin_amdgcn_mfma_f32_16x16x32_bf16(Bt[n][k], At[m][k], acc[ai][bj][m][n], 0, 0, 0); __builtin_amdgcn_s_setprio(0); } while (0)
#define PG8_WAIT_V(n) asm volatile("s_waitcnt vmcnt(" #n ")" ::: "memory")
#define PG8_WAIT_L(n) asm volatile("s_waitcnt lgkmcnt(" #n ")" ::: "memory")
#define PG8_BAR __builtin_amdgcn_s_barrier()
#define PG8_SCHED __builtin_amdgcn_sched_barrier(0)
#define PG8_KA(t) ((t) < ntH ? cA + (size_t)(t) * kstep : cA2 + (size_t)((t) - ntH) * kstep)
#define PG8_KB(t) ((t) < ntH ? cB + (size_t)(t) * kstep : cB2 + (size_t)((t) - ntH) * kstep)
  Unit cur, nxt; int ui = 0;
  if (!S.next(0, cur)) return;
  f32x4 acc[2][2][4][2];
#pragma unroll
  for (int a = 0; a < 2; ++a)
#pragma unroll
    for (int b = 0; b < 2; ++b)
#pragma unroll
      for (int m = 0; m < 4; ++m)
#pragma unroll
        for (int n = 0; n < 2; ++n) acc[a][b][m][n] = (f32x4){0.f, 0.f, 0.f, 0.f};
  bf16x8 At[4][2], B0[2][2], B1[2][2];
  const char* cA = (const char*)g.A + (size_t)cur.pm * tstep; const char* cB = (const char*)g.Bt + (size_t)cur.pn * tstep;
  const char* cA2 = g.A2 ? (const char*)g.A2 + (size_t)cur.pm * tstep : cA; const char* cB2 = g.A2 ? (const char*)g.Bt2 + (size_t)cur.pn * tstep : cB;
  PG8_STAGE(PG8_SB(0, 0), cB, voffB); PG8_STAGE(PG8_SA(0, 0), cA, voffA); PG8_STAGE(PG8_SB(0, 1), cB + hstep, voffB); PG8_STAGE(PG8_SA(0, 1), cA + hstep, voffA);
  if (wr == 1) PG8_BAR;
  PG8_WAIT_V(4); PG8_BAR;
  PG8_STAGE(PG8_SB(1, 0), cB + kstep, voffB); PG8_STAGE(PG8_SA(1, 0), cA + kstep, voffA); PG8_STAGE(PG8_SB(1, 1), cB + hstep + kstep, voffB);
  PG8_WAIT_V(6); PG8_BAR;
  for (;;) {
    const bool has_next = S.next(ui + 1, nxt);
    const char* nA = has_next ? (const char*)g.A + (size_t)nxt.pm * tstep : cA; const char* nB = has_next ? (const char*)g.Bt + (size_t)nxt.pn * tstep : cB;
    for (int t = 0; t < nt; t += 2) {
      const bool last = (t == nt - 2);
      const char* a1 = PG8_KA(t + 1);
      const char* a2 = last ? nA : PG8_KA(t + 2); const char* b2 = last ? nB : PG8_KB(t + 2);
      const char* a3 = a2 + kstep; const char* b3 = b2 + kstep;
      PG8_LDB(B0, 0, 0); PG8_SCHED; PG8_LDA(At, 0, 0); PG8_STAGE(PG8_SA(1, 1), a1 + hstep, voffA);
      PG8_WAIT_L(8); PG8_BAR; PG8_WAIT_L(0); PG8_MMA(0, 0, At, B0); PG8_BAR; PG8_SCHED;
      PG8_LDB(B1, 0, 1); PG8_STAGE(PG8_SB(0, 0), b2, voffB);
      PG8_BAR; PG8_WAIT_L(0); PG8_MMA(0, 1, At, B1); PG8_BAR;
      PG8_LDA(At, 0, 1); PG8_STAGE(PG8_SA(0, 0), a2, voffA);
      PG8_BAR; PG8_WAIT_L(0); PG8_MMA(1, 0, At, B0); PG8_BAR; PG8_SCHED;
      PG8_STAGE(PG8_SB(0, 1), b2 + hstep, voffB);
      PG8_WAIT_V(6); PG8_BAR; PG8_MMA(1, 1, At, B1); PG8_BAR;
      PG8_LDB(B0, 1, 0); PG8_SCHED; PG8_LDA(At, 1, 0); PG8_STAGE(PG8_SA(0, 1), a2 + hstep, voffA);
      PG8_WAIT_L(8); PG8_BAR; PG8_WAIT_L(0); PG8_MMA(0, 0, At, B0); PG8_BAR; PG8_SCHED;
      PG8_LDB(B1, 1, 1); PG8_STAGE(PG8_SB(1, 0), b3, voffB);
      PG8_BAR; PG8_WAIT_L(0); PG8_MMA(0, 1, At, B1); PG8_BAR;
      PG8_LDA(At, 1, 1); PG8_STAGE(PG8_SA(1, 0), a3, voffA);
      PG8_BAR; PG8_WAIT_L(0); PG8_MMA(1, 0, At, B0); PG8_BAR; PG8_SCHED;
      PG8_STAGE(PG8_SB(1, 1), b3 + hstep, voffB);
      PG8_WAIT_V(6); PG8_BAR; PG8_MMA(1, 1, At, B1); PG8_BAR;
      if (Epi::HASMID && t == ntH - 2) E.mid(acc, cur, wr, wc, fr, fq);
    }
    E(acc, cur, wr, wc, fr, fq);
    if (!has_next) break;
#pragma unroll
    for (int a = 0; a < 2; ++a)
#pragma unroll
      for (int b = 0; b < 2; ++b)
#pragma unroll
        for (int m = 0; m < 4; ++m)
#pragma unroll
          for (int n = 0; n < 2; ++n) acc[a][b][m][n] = (f32x4){0.f, 0.f, 0.f, 0.f};
    cur = nxt; cA = nA; cB = nB; ++ui;
    cA2 = g.A2 ? (const char*)g.A2 + (size_t)cur.pm * tstep : cA; cB2 = g.A2 ? (const char*)g.Bt2 + (size_t)cur.pn * tstep : cB;
  }
  PG8_WAIT_V(0);
  if (wr == 0) PG8_BAR;
  PG8_BAR;
#undef PG8_SA
#undef PG8_SB
#undef PG8_STAGE
#undef PG8_LDA
#undef PG8_LDB
#undef PG8_MMA
#undef PG8_WAIT_V
#undef PG8_WAIT_L
#undef PG8_BAR
#undef PG8_SCHED
#undef PG8_KA
#undef PG8_KB
}
}

struct EpiP2 {
  static constexpr bool HASMID = false;
  char* ws;
  DI void mid(f32x4 (&)[2][2][4][2], const pg8::Unit&, int, int, int, int) const {}
  DI void operator()(const f32x4 (&acc)[2][2][4][2], const pg8::Unit& u, int wr, int wc, int fr, int fq) const {
    u16* P = (u16*)(ws + OFF_P);
    const int m0 = u.pm * 256;
    const int bgrow = (m0 >> 12) * 2;
    const size_t mb = (size_t)(m0 & ~4095);
#pragma unroll
    for (int bj = 0; bj < 2; ++bj) {
      const int colg = u.pn * 256 + bj * 128 + wc * 32;
      const int cg = colg >> 6, sub = colg & 63;
      const bool vgrp = (cg == 14) || (cg == 15) || (cg == 18) || (cg == 19) || (cg == 38) || (cg == 39);
      if (vgrp) {
        u16* VT = (u16*)(ws + (cg < 16 ? OFF_VTS : (cg < 20 ? OFF_VTW : OFF_VTB))) + (size_t)(bgrow + (cg & 1)) * (64 * 4096);
#pragma unroll
        for (int ai = 0; ai < 2; ++ai)
#pragma unroll
          for (int m = 0; m < 4; ++m) {
            const int s = (m0 + ai * 128 + wr * 64 + m * 16 + fr) & 4095;
#pragma unroll
            for (int n = 0; n < 2; ++n) {
              const int d = sub + n * 16 + 4 * fq;
              u16* dst = VT + (size_t)(s >> 5) * 2048 + d * 32 + (s & 31);
              const f32x4 v = acc[ai][bj][m][n];
              unsigned p01 = pack2(v[0], v[1]), p23 = pack2(v[2], v[3]);
              dst[0] = (u16)(p01 & 0xffffu);
              dst[32] = (u16)(p01 >> 16);
              dst[64] = (u16)(p23 & 0xffffu);
              dst[96] = (u16)(p23 >> 16);
            }
          }
      } else {
        int mode;
        u16* dstb;
        int dld;
        if (cg < 8) { mode = 1; dstb = P + C_QA + cg * 64; dld = LDP; }
        else if (cg < 12) { mode = 0; dstb = (u16*)(ws + OFF_KCR) + (size_t)(((cg - 8) >> 1) * 8 + bgrow + (cg & 1)) * 4096 * 64 - mb * 64; dld = 64; }
        else if (cg < 20) { mode = 0; dstb = (u16*)(ws + (cg < 16 ? OFF_KS : OFF_KW)) + (size_t)(bgrow + (cg & 1)) * 4096 * 64 - mb * 64; dld = 64; }
        else if (cg < 28) { mode = 2; dstb = P + C_ZA + (cg - 20) * 64; dld = LDP; }
        else if (cg < 36) { mode = 1; dstb = P + C_QB + (cg - 28) * 64; dld = LDP; }
        else if (cg < 40) { mode = 0; dstb = (u16*)(ws + OFF_KB) + (size_t)(bgrow + (cg & 1)) * 4096 * 64 - mb * 64; dld = 64; }
        else if (cg < 48) { mode = 2; dstb = P + C_ZB + (cg - 40) * 64; dld = LDP; }
        else { mode = 3; dstb = P + C_MA + (cg - 48) * 64; dld = LDP; }
        const bool lin_one = (mode == 3), use_sig = (mode >= 2);
        const float mul = (mode == 1) ? 0.125f * 1.44269504f : 1.f;
#pragma unroll
        for (int ai = 0; ai < 2; ++ai)
#pragma unroll
          for (int m = 0; m < 4; ++m) {
            const int tok = m0 + ai * 128 + wr * 64 + m * 16 + fr;
            u16* rowp = dstb + (size_t)tok * dld + sub + 4 * fq;
#pragma unroll
            for (int n = 0; n < 2; ++n) {
              const f32x4 a = acc[ai][bj][m][n];
              u32x2 o;
              if (use_sig) {
                const float s0 = sigmoidf_(a[0]), s1 = sigmoidf_(a[1]), s2 = sigmoidf_(a[2]), s3 = sigmoidf_(a[3]);
                o = (u32x2){pack2(lin_one ? s0 : a[0] * s0, lin_one ? s1 : a[1] * s1), pack2(lin_one ? s2 : a[2] * s2, lin_one ? s3 : a[3] * s3)};
              } else {
                o = (u32x2){pack2(a[0] * mul, a[1] * mul), pack2(a[2] * mul, a[3] * mul)};
              }
              *(u32x2*)(rowp + n * 16) = o;
            }
          }
      }
    }
  }
};

__device__ void phase2(const Params& p, char* smem) {
  char* ws = p.ws;
  const int t = threadIdx.x, lane = t & 63, wave = t >> 6, quad = lane >> 4, l15 = lane & 15;
  {
    pg8::Gemm g{(const u16*)(ws + OFF_H), (const u16*)(ws + OFF_WTIN), nullptr, nullptr, T_TOK, 5120, 1024};
    pg8::StaticOrder S;
    S.init(g.M, g.N, (int)gridDim.x, (int)blockIdx.x);
    EpiP2 E{ws};
    __syncthreads();
    pg8::gemm_phase(( PG8_LAS unsigned char*)smem, g, S, E);
  }
  struct { const u16 *H, *W; } geom{(const u16*)(ws + OFF_H), (const u16*)(ws + OFF_WTIN)};
  {
    const u16* H = geom.H;
    const u16* Wg = geom.W + (size_t)5120 * 1024;
    u16* GN = (u16*)(ws + OFF_GN);
    const int nwv = gridDim.x * 8;
    for (int it = blockIdx.x * 8 + wave; it < 1024; it += nwv) {
      const int tok0 = it * 16;
      f32x4 c0 = (f32x4){0.f, 0.f, 0.f, 0.f}, c1 = c0;
      const u16* hp = H + (size_t)(tok0 + l15) * 1024 + quad * 8;
      const u16* wp = Wg + (size_t)l15 * 1024 + quad * 8;
#pragma unroll 8
      for (int ks = 0; ks < 32; ++ks) {
        bf16x8 hf = *(const bf16x8*)(hp + ks * 32);
        bf16x8 w0 = *(const bf16x8*)(wp + ks * 32);
        bf16x8 w1 = *(const bf16x8*)(wp + 16 * 1024 + ks * 32);
        c0 = MFMA16(w0, hf, c0);
        c1 = MFMA16(w1, hf, c1);
      }
      u32x2 o0 = {pack2(sigmoidf_(c0[0]), sigmoidf_(c0[1])), pack2(sigmoidf_(c0[2]), sigmoidf_(c0[3]))};
      u32x2 o1 = {pack2(sigmoidf_(c1[0]), sigmoidf_(c1[1])), pack2(sigmoidf_(c1[2]), sigmoidf_(c1[3]))};
      *(u32x2*)(GN + (size_t)(tok0 + l15) * 32 + quad * 4) = o0;
      *(u32x2*)(GN + (size_t)(tok0 + l15) * 32 + 16 + quad * 4) = o1;
    }
  }
}

__device__ void phase3(const Params& p, char* smem) {
  const u16* KCR = (const u16*)(p.ws + OFF_KCR);
  const float* bias1 = (const float*)(p.ws + OFF_BIASP);
  const int t = threadIdx.x, lane = t & 63, wave = t >> 6, quad = lane >> 4, l15 = lane & 15;
  u16* hs = (u16*)smem;
  for (int item = blockIdx.x; item < 256; item += gridDim.x) {
    const int kv = item >> 7, bg = (item >> 4) & 7, ct = item & 15;
    const int b = bg >> 1, g = bg & 1, c0 = ct * 16;
    const u16* Wt1 = (const u16*)(p.ws + (kv ? OFF_WT1V : OFF_WT1K));
    const u16* Wt2 = (const u16*)(p.ws + (kv ? OFF_WT2V : OFF_WT2K));
    const u16* arow = KCR + (size_t)(kv * 8 + bg) * 4096 * 64;
    const int crow = c0 + l15;
    f32x4 acc[2];
    acc[0] = (f32x4){0.f, 0.f, 0.f, 0.f};
    acc[1] = acc[0];
    const u16* wb = Wt1 + (size_t)(wave * 32 + l15) * 2048 + quad * 8;
#pragma unroll 8
    for (int ks = 0; ks < 64; ++ks) {
      int tokl = 16 * crow + (ks >> 1);
      tokl = tokl > 4095 ? 4095 : tokl;
      bf16x8 af = *(const bf16x8*)(arow + (size_t)tokl * 64 + (ks & 1) * 32 + quad * 8);
#pragma unroll
      for (int j = 0; j < 2; ++j) {
        bf16x8 bfr = *(const bf16x8*)(wb + (size_t)(j * 16) * 2048 + ks * 32);
        acc[j] = MFMA16(af, bfr, acc[j]);
      }
    }
    __syncthreads();
#pragma unroll
    for (int j = 0; j < 2; ++j) {
      const int n = wave * 32 + j * 16 + l15;
      float bb = 0.f;
#pragma unroll 8
      for (int kc = 0; kc < 32; ++kc) bb += bias1[(kv * 32 + kc) * 256 + n];
#pragma unroll
      for (int r = 0; r < 4; ++r) {
        float hval = siluf_(acc[j][r] + bb);
        hs[(quad * 4 + r) * 264 + n] = (u16)(pack2(hval, 0.f) & 0xffffu);
      }
    }
    __syncthreads();
    if (wave < 4) {
      f32x4 o = (f32x4){0.f, 0.f, 0.f, 0.f};
#pragma unroll
      for (int ks = 0; ks < 8; ++ks) {
        bf16x8 hf = *(const bf16x8*)(hs + l15 * 264 + ks * 32 + quad * 8);
        bf16x8 wf = *(const bf16x8*)(Wt2 + (size_t)(wave * 16 + l15) * 256 + ks * 32 + quad * 8);
        if (kv == 0) o = MFMA16(wf, hf, o);
        else o = MFMA16(hf, wf, o);
      }
      if (kv == 0) {
        u16* KC = (u16*)(p.ws + OFF_KC);
        const int c = c0 + l15;
        u32x2 ov = {pack2(o[0], o[1]), pack2(o[2], o[3])};
        if (c == 255) ov = (u32x2){0u, 0u};
        *(u32x2*)(KC + (size_t)(bg * 256 + c) * 64 + wave * 16 + quad * 4) = ov;
      } else {
        u16* VCT = (u16*)(p.ws + OFF_VCT);
        const int cb = c0 + quad * 4;
        float o3 = (cb + 3 == 255) ? 0.f : o[3];
        u32x2 ov = {pack2(o[0], o[1]), pack2(o[2], o3)};
        *(u32x2*)(VCT + (size_t)(bg * 64 + wave * 16 + l15) * 256 + cb) = ov;
      }
    }
  }
}

struct QF {
  const char* base;
  DI bf16x8 get(int nt, int kk) const {
    int off = (nt * 2 + kk) * 1024;
    asm volatile("" : "+v"(off));
    return *(const bf16x8*)(base + off);
  }
};

DI void load_q(QF& qf, char* qslot, const u16* P, int tokbase, int qcol, int lane) {
  const u16* q = P + (size_t)(tokbase + (lane & 15)) * LDP + qcol + (lane >> 4) * 8;
  char* dst = qslot + lane * 16;
#pragma unroll
  for (int nt = 0; nt < 4; ++nt) {
    *(bf16x8*)(dst + (nt * 2 + 0) * 1024) = *(const bf16x8*)(q + nt * 64);
    *(bf16x8*)(dst + (nt * 2 + 1) * 1024) = *(const bf16x8*)(q + nt * 64 + 32);
  }
  qf.base = dst;
}

DI void qk_step(const QF& qf, const u16* kptr, size_t kstride, int lane, f32x4 (&s)[2][4]) {
#pragma unroll
  for (int kt2 = 0; kt2 < 2; ++kt2) {
    const u16* kp = kptr + (size_t)(kt2 * 16 + (lane & 15)) * kstride + (lane >> 4) * 8;
    bf16x8 k0 = *(const bf16x8*)(kp), k1 = *(const bf16x8*)(kp + 32);
#pragma unroll
    for (int nt = 0; nt < 4; ++nt) {
      f32x4 z = (f32x4){0.f, 0.f, 0.f, 0.f};
      z = MFMA16(k0, qf.get(nt, 0), z);
      s[kt2][nt] = MFMA16(k1, qf.get(nt, 1), z);
    }
  }
}

DI void pv_step(const bf16x8 (&pf)[4], const u16* vtptr, size_t vtstride, int lane, f32x4 (&o)[4][4]) {
#pragma unroll
  for (int dt = 0; dt < 4; ++dt) {
    const u16* vp = vtptr + (size_t)(dt * 16 + (lane & 15)) * vtstride + (lane >> 4) * 4;
    bf16x4 lo = *(const bf16x4*)vp, hi = *(const bf16x4*)(vp + 16);
    bf16x8 vf = __builtin_shufflevector(lo, hi, 0, 1, 2, 3, 4, 5, 6, 7);
#pragma unroll
    for (int nt = 0; nt < 4; ++nt) o[dt][nt] = MFMA16(vf, pf[nt], o[dt][nt]);
  }
}

DI bf16x8 pack8(const float (&pv)[8]) {
  unsigned a = pack2(pv[0], pv[1]), b = pack2(pv[2], pv[3]), c = pack2(pv[4], pv[5]), d = pack2(pv[6], pv[7]);
  u32x4 u = {a, b, c, d};
  return __builtin_bit_cast(bf16x8, u);
}

DI float ex2(float x) { return __builtin_amdgcn_exp2f(x); }

struct KV { bf16x8 kf[2][2]; const u16* vp; };
DI void load_kv(KV& kv, const u16* kptr, size_t kstride, const u16* vtptr, size_t vtstride, int lane) {
#pragma unroll
  for (int kt2 = 0; kt2 < 2; ++kt2) {
    const u16* kp = kptr + (size_t)(kt2 * 16 + (lane & 15)) * kstride + (lane >> 4) * 8;
    kv.kf[kt2][0] = *(const bf16x8*)(kp);
    kv.kf[kt2][1] = *(const bf16x8*)(kp + 32);
  }
  kv.vp = vtptr + (size_t)(lane & 15) * vtstride + (lane >> 4) * 4;
}

template <class MaskF>
DI void attn_compute(const QF& qf, const KV& kv, size_t vtstride, const float (&slope)[4], float (&m)[4],
                     float (&l)[4], f32x4 (&o)[4][4], bool allvalid, MaskF maskf) {
  bf16x8 vf[4];
#pragma unroll
  for (int dt = 0; dt < 4; ++dt) {
    const u16* vp = kv.vp + (size_t)(dt * 16) * vtstride;
    bf16x4 lo = *(const bf16x4*)vp, hi = *(const bf16x4*)(vp + 16);
    vf[dt] = __builtin_shufflevector(lo, hi, 0, 1, 2, 3, 4, 5, 6, 7);
  }
  float fd[8];
  bool valid[8];
#pragma unroll
  for (int kt2 = 0; kt2 < 2; ++kt2)
#pragma unroll
    for (int r = 0; r < 4; ++r) maskf(kt2, r, fd[kt2 * 4 + r], valid[kt2 * 4 + r]);
  bf16x8 pf[4];
#pragma unroll
  for (int nt = 0; nt < 4; ++nt) {
    f32x4 s0 = (f32x4){0.f, 0.f, 0.f, 0.f}, s1 = s0;
    const bf16x8 q0 = qf.get(nt, 0), q1 = qf.get(nt, 1);
    s0 = MFMA16(kv.kf[0][0], q0, s0);
    s0 = MFMA16(kv.kf[0][1], q1, s0);
    s1 = MFMA16(kv.kf[1][0], q0, s1);
    s1 = MFMA16(kv.kf[1][1], q1, s1);
    float sv[8];
    float mx = NEGF;
    if (allvalid) {
#pragma unroll
      for (int r = 0; r < 4; ++r) {
        sv[r] = s0[r] - slope[nt] * fd[r];
        sv[4 + r] = s1[r] - slope[nt] * fd[4 + r];
        mx = fmaxf(mx, fmaxf(sv[r], sv[4 + r]));
      }
    } else {
#pragma unroll
      for (int r = 0; r < 4; ++r) {
        sv[r] = valid[r] ? s0[r] - slope[nt] * fd[r] : NEGF;
        sv[4 + r] = valid[4 + r] ? s1[r] - slope[nt] * fd[4 + r] : NEGF;
        mx = fmaxf(mx, fmaxf(sv[r], sv[4 + r]));
      }
    }
    if (__any(mx > m[nt] + 8.f)) {
      mx = fmaxf(mx, __shfl_xor(mx, 16));
      mx = fmaxf(mx, __shfl_xor(mx, 32));
      const float mnew = fmaxf(m[nt], mx);
      const float alpha = ex2(m[nt] - mnew);
      m[nt] = mnew;
      l[nt] *= alpha;
#pragma unroll
      for (int dt = 0; dt < 4; ++dt) o[dt][nt] *= alpha;
    }
    float pv[8];
    float ps = 0.f;
    if (allvalid) {
#pragma unroll
      for (int i = 0; i < 8; ++i) {
        pv[i] = ex2(sv[i] - m[nt]);
        ps += pv[i];
      }
    } else {
#pragma unroll
      for (int i = 0; i < 8; ++i) {
        pv[i] = valid[i] ? ex2(sv[i] - m[nt]) : 0.f;
        ps += pv[i];
      }
    }
    l[nt] += ps;
    pf[nt] = pack8(pv);
  }
#pragma unroll
  for (int dt = 0; dt < 4; ++dt)
#pragma unroll
    for (int nt = 0; nt < 4; ++nt) o[dt][nt] = MFMA16(vf[dt], pf[nt], o[dt][nt]);
}

template <class NextF, class LoadF, class CompF>
DI void attn_pipeline(NextF next, LoadF load, CompF comp) {
  int k0 = next();
  if (k0 < 0) return;
  KV cur;
  load(cur, k0);
  while (true) {
    const int k1 = next();
    KV nxt = cur;
    if (k1 >= 0) load(nxt, k1);
    comp(cur, k0);
    if (k1 < 0) break;
    cur = nxt;
    k0 = k1;
  }
}

DI void softmax_step(f32x4 (&s)[2][4], float (&m)[4], float (&l)[4], f32x4 (&o)[4][4], bf16x8 (&pf)[4]) {
#pragma unroll
  for (int nt = 0; nt < 4; ++nt) {
    float mx = NEGF;
#pragma unroll
    for (int kt2 = 0; kt2 < 2; ++kt2)
#pragma unroll
      for (int r = 0; r < 4; ++r) mx = fmaxf(mx, s[kt2][nt][r]);
    mx = fmaxf(mx, __shfl_xor(mx, 16));
    mx = fmaxf(mx, __shfl_xor(mx, 32));
    const float mnew = fmaxf(m[nt], mx);
    const float alpha = __expf(m[nt] - mnew);
    m[nt] = mnew;
    float pv[8];
    float ps = 0.f;
#pragma unroll
    for (int kt2 = 0; kt2 < 2; ++kt2)
#pragma unroll
      for (int r = 0; r < 4; ++r) {
        float sv = s[kt2][nt][r];
        float e = (sv > -5e29f) ? __expf(sv - mnew) : 0.f;
        pv[kt2 * 4 + r] = e;
        ps += e;
      }
    l[nt] = l[nt] * alpha + ps;
#pragma unroll
    for (int dt = 0; dt < 4; ++dt) o[dt][nt] *= alpha;
    pf[nt] = pack8(pv);
  }
}

DI void init_state(float (&m)[4], float (&l)[4], f32x4 (&o)[4][4]) {
#pragma unroll
  for (int nt = 0; nt < 4; ++nt) { m[nt] = NEGF; l[nt] = 0.f; }
  zero_acc(o);
}
DI float quad_sum(float v) { v += __shfl_xor(v, 16); v += __shfl_xor(v, 32); return v; }

DI void accum_gated(f32x4 (&tot)[4][4], const f32x4 (&o)[4][4], const float (&l)[4], const float (&gate)[4]) {
#pragma unroll
  for (int nt = 0; nt < 4; ++nt) {
    float lt = quad_sum(l[nt]);
    float sc = lt > 0.f ? gate[nt] / lt : 0.f;
#pragma unroll
    for (int dt = 0; dt < 4; ++dt) tot[dt][nt] += o[dt][nt] * sc;
  }
}

template <int W>
DI void banded_attn(const QF& qf, const u16* kbase, int t0, const u16* vt, int lane,
                    const float (&slope)[4], float (&m)[4], float (&l)[4], f32x4 (&o)[4][4]) {
  const int tok = t0 + (lane & 15), quad = lane >> 4;
  int kstart = t0 - (W - 1);
  kstart = kstart < 0 ? 0 : (kstart & ~31);
  int knext = kstart;
  attn_pipeline(
      [&]() { int k = knext; knext += 32; return (k <= t0 + 15) ? k : -1; },
      [&](KV& kv, int key0) { load_kv(kv, kbase + (size_t)key0 * 64, 64, vt + (size_t)key0 * 64, 32, lane); },
      [&](const KV& kv, int key0) {
        attn_compute(qf, kv, 32, slope, m, l, o, (key0 + 31 <= t0) && (key0 >= t0 + 15 - (W - 1)),
                     [&](int kt2, int r, float& fd, bool& valid) {
                       const int dist = tok - (key0 + kt2 * 16 + quad * 4 + r);
                       valid = (dist >= 0) && (dist < W);
                       fd = (float)dist;
                     });
      });
}
DI void tot_store(float* TOT, size_t grow, int g, int quad, const f32x4 (&o)[4][4], const float (&sc)[4], bool add) {
#pragma unroll
  for (int nt = 0; nt < 4; ++nt)
#pragma unroll
    for (int dt = 0; dt < 4; ++dt) {
      f32x4* ptr = (f32x4*)(TOT + grow * 512 + (g * 4 + nt) * 64 + dt * 16 + quad * 4);
      f32x4 v = o[dt][nt] * sc[nt];
      if (add) v += *ptr;
      *ptr = v;
    }
}

__device__ void nsa_item(const Params& p, int item, char* smem) {
  const u16* P = (const u16*)(p.ws + OFF_P);
  const u16* GN = (const u16*)(p.ws + OFF_GN);
  float* TOT = (float*)(p.ws + OFF_U);
  const int t = threadIdx.x, lane = t & 63, wave = t >> 6, quad = lane >> 4, l15 = lane & 15;
  const int bg = item >> 5, tb0 = (item & 31) * 128;
  const int b = bg >> 1, g = bg & 1;
  const int t0 = tb0 + wave * 16, tok = t0 + l15;
  const size_t grow = (size_t)(b * 4096 + tok);
  QF qf;
  load_q(qf, smem + 66560 + wave * 8192, P, b * 4096 + t0, C_QA + g * 256, lane);
  float slope[4];
#pragma unroll
  for (int nt = 0; nt < 4; ++nt) slope[nt] = exp2f(-(float)(g * 4 + nt + 1)) * 1.44269504f;
  float m[4], l[4];
  f32x4 o[4][4];
  float gate[4];

  const u16* KC = (const u16*)(p.ws + OFF_KC) + (size_t)bg * 256 * 64;
  const u16* VCT = (const u16*)(p.ws + OFF_VCT) + (size_t)bg * 64 * 256;
  const int ncv = (tb0 + 127 >= 31) ? (((tb0 + 127 - 31) >> 4) + 1) : 0;
  const int steps = (ncv + 31) >> 5;
#pragma unroll
  for (int nt = 0; nt < 4; ++nt) { m[nt] = NEGF; l[nt] = 0.f; }
  for (int st = 0; st < steps; ++st) {
    f32x4 s[2][4];
    qk_step(qf, KC + (size_t)(st * 32) * 64, 64, lane, s);
#pragma unroll
    for (int nt = 0; nt < 4; ++nt) {
      float mx = NEGF;
#pragma unroll
      for (int kt2 = 0; kt2 < 2; ++kt2)
#pragma unroll
        for (int r = 0; r < 4; ++r) {
          const int c = st * 32 + kt2 * 16 + quad * 4 + r;
          const int dist = tok - (16 * c + 31);
          float sv = (dist >= 0) ? s[kt2][nt][r] - slope[nt] * (float)dist : NEGF;
          s[kt2][nt][r] = sv;
          mx = fmaxf(mx, sv);
        }
      mx = fmaxf(mx, __shfl_xor(mx, 16));
      mx = fmaxf(mx, __shfl_xor(mx, 32));
      const float mnew = fmaxf(m[nt], mx);
      float ps = 0.f;
#pragma unroll
      for (int kt2 = 0; kt2 < 2; ++kt2)
#pragma unroll
        for (int r = 0; r < 4; ++r) {
          float sv = s[kt2][nt][r];
          ps += (sv > -5e29f) ? ex2(sv - mnew) : 0.f;
        }
      l[nt] = l[nt] * ex2(m[nt] - mnew) + ps;
      m[nt] = mnew;
    }
  }
  float invl[4];
#pragma unroll
  for (int nt = 0; nt < 4; ++nt) {
    float lt = quad_sum(l[nt]);
    invl[nt] = lt > 0.f ? 1.f / lt : 0.f;
  }
  float2* xy = (float2*)smem + wave * (16 * 65);
  __syncthreads();
  for (int j = steps * 8 + quad; j < 64; j += 4) xy[l15 * 65 + j] = (float2){0.f, 0.f};
  zero_acc(o);
  for (int st = 0; st < steps; ++st) {
    bf16x8 kf[2][2];
#pragma unroll
    for (int kt2 = 0; kt2 < 2; ++kt2) {
      const u16* kp = KC + (size_t)(st * 32 + kt2 * 16 + l15) * 64 + quad * 8;
      kf[kt2][0] = *(const bf16x8*)(kp);
      kf[kt2][1] = *(const bf16x8*)(kp + 32);
    }
    bf16x8 pf[4];
    float psum[8];
#pragma unroll
    for (int i = 0; i < 8; ++i) psum[i] = 0.f;
#pragma unroll
    for (int nt = 0; nt < 4; ++nt) {
      f32x4 s0 = (f32x4){0.f, 0.f, 0.f, 0.f}, s1 = s0;
      const bf16x8 q0 = qf.get(nt, 0), q1 = qf.get(nt, 1);
      s0 = MFMA16(kf[0][0], q0, s0);
      s0 = MFMA16(kf[0][1], q1, s0);
      s1 = MFMA16(kf[1][0], q0, s1);
      s1 = MFMA16(kf[1][1], q1, s1);
      float pv[8];
#pragma unroll
      for (int kt2 = 0; kt2 < 2; ++kt2)
#pragma unroll
        for (int r = 0; r < 4; ++r) {
          const int c = st * 32 + kt2 * 16 + quad * 4 + r;
          const int dist = tok - (16 * c + 31);
          float sv = (kt2 ? s1[r] : s0[r]) - slope[nt] * (float)dist;
          float e = (dist >= 0) ? ex2(sv - m[nt]) * invl[nt] : 0.f;
          pv[kt2 * 4 + r] = e;
          psum[kt2 * 4 + r] += e;
        }
      pf[nt] = pack8(pv);
    }
#pragma unroll
    for (int kt2 = 0; kt2 < 2; ++kt2) {
      float X = psum[kt2 * 4], Y = X + 2.f * (psum[kt2 * 4 + 1] + psum[kt2 * 4 + 2] + psum[kt2 * 4 + 3]);
      xy[l15 * 65 + (st * 2 + kt2) * 4 + quad] = (float2){X, Y};
    }
    pv_step(pf, VCT + st * 32, 256, lane, o);
  }
#pragma unroll
  for (int nt = 0; nt < 4; ++nt) gate[nt] = bf2f(GN[grow * 32 + 0 * 8 + g * 4 + nt]);
  tot_store(TOT, grow, g, quad, o, gate, false);
  __syncthreads();
  unsigned mlo = 0u, mhi = 0u;
  if (lane < 16) {
    const int tp = t0 + lane, cur = tp >> 6;
    float* sc = (float*)(xy + lane * 65);
    float prevY = 0.f;
    for (int jb = 0; jb < 64; ++jb) {
      float2 v = xy[lane * 65 + jb];
      float imp = v.x + prevY;
      prevY = v.y;
      const bool causal = jb <= cur;
      const bool forced = (jb == 0) | (jb == cur) | (jb == cur - 1);
      sc[jb] = causal ? (forced ? 1e30f : imp) : -1e30f;
    }
    for (int it = 0; it < 16; ++it) {
      float best = -3.0e38f;
      int bi = 0;
      for (int jb = 0; jb < 64; ++jb) {
        float v = sc[jb];
        if (v > best) { best = v; bi = jb; }
      }
      sc[bi] = -3.4e38f;
      if (bi <= cur) {
        if (bi < 32) mlo |= 1u << bi; else mhi |= 1u << (bi - 32);
      }
    }
  }
  mlo = __shfl(mlo, l15);
  mhi = __shfl(mhi, l15);

  {
    init_state(m, l, o);
    const u16* vt = (const u16*)(p.ws + OFF_VTS) + (size_t)bg * 64 * 4096;
    unsigned ulo = mlo, uhi = mhi;
#pragma unroll
    for (int sh = 1; sh < 16; sh <<= 1) { ulo |= __shfl_xor(ulo, sh); uhi |= __shfl_xor(uhi, sh); }
    ulo = __builtin_amdgcn_readfirstlane(ulo);
    uhi = __builtin_amdgcn_readfirstlane(uhi);
    unsigned long long um = ((unsigned long long)uhi << 32) | ulo;
    int pend = -1;
    const u16* kbase = (const u16*)(p.ws + OFF_KS) + (size_t)bg * 4096 * 64;
    attn_pipeline(
        [&]() {
          if (pend >= 0) { int k = pend; pend = -1; return k; }
          if (um == 0ull) return -1;
          const int jb = __builtin_ctzll(um);
          um &= um - 1ull;
          const int k = jb * 64;
          if (k + 32 <= t0 + 15) pend = k + 32;
          return k;
        },
        [&](KV& kv, int key0) { load_kv(kv, kbase + (size_t)key0 * 64, 64, vt + (size_t)key0 * 64, 32, lane); },
        [&](const KV& kv, int key0) {
          const int jb = key0 >> 6;
          const bool mine = (jb < 32) ? ((mlo >> jb) & 1u) : ((mhi >> (jb - 32)) & 1u);
          attn_compute(qf, kv, 32, slope, m, l, o, __all(mine) && (key0 + 31 <= t0),
                       [&](int kt2, int r, float& fd, bool& valid) {
                         const int dist = tok - (key0 + kt2 * 16 + quad * 4 + r);
                         valid = mine && (dist >= 0);
                         fd = (float)dist;
                       });
        });
    float scl[4];
#pragma unroll
    for (int nt = 0; nt < 4; ++nt) {
      float lt = quad_sum(l[nt]);
      scl[nt] = lt > 0.f ? bf2f(GN[grow * 32 + 1 * 8 + g * 4 + nt]) / lt : 0.f;
    }
    tot_store(TOT, grow, g, quad, o, scl, true);
  }
  {
    init_state(m, l, o);
    const u16* vt = (const u16*)(p.ws + OFF_VTW) + (size_t)bg * 64 * 4096;
    banded_attn<512>(qf, (const u16*)(p.ws + OFF_KW) + (size_t)bg * 4096 * 64, t0, vt, lane, slope, m, l, o);
    u16* OA = (u16*)(p.ws + OFF_H);
#pragma unroll
    for (int nt = 0; nt < 4; ++nt) {
      float lt = quad_sum(l[nt]);
      const float scw = lt > 0.f ? bf2f(GN[grow * 32 + 2 * 8 + g * 4 + nt]) / lt : 0.f;
#pragma unroll
      for (int dt = 0; dt < 4; ++dt) {
        const int col = (g * 4 + nt) * 64 + dt * 16 + quad * 4;
        f32x4 tv = *(const f32x4*)(TOT + grow * 512 + col) + o[dt][nt] * scw;
        u32x2 z = *(const u32x2*)(P + grow * LDP + C_ZA + col);
        u32x2 ov = {pack2(tv[0] * bflo(z.x), tv[1] * bfhi(z.x)), pack2(tv[2] * bflo(z.y), tv[3] * bfhi(z.y))};
        *(u32x2*)(OA + grow * 512 + col) = ov;
      }
    }
  }
}

__device__ void swa_item(const Params& p, int item, char* smem) {
  const u16* P = (const u16*)(p.ws + OFF_P);
  const int t = threadIdx.x, lane = t & 63, wave = t >> 6, quad = lane >> 4, l15 = lane & 15;
  const int bg = item >> 5, tb0 = (item & 31) * 128;
  const int b = bg >> 1, g = bg & 1;
  const int t0 = tb0 + wave * 16, tok = t0 + l15;
  const size_t grow = (size_t)(b * 4096 + tok);
  QF qf;
  load_q(qf, smem + 66560 + wave * 8192, P, b * 4096 + t0, C_QB + g * 256, lane);
  float slope[4];
#pragma unroll
  for (int nt = 0; nt < 4; ++nt) slope[nt] = exp2f(-(float)(g * 4 + nt + 1)) * 1.44269504f;
  float m[4], l[4];
  f32x4 o[4][4];
  init_state(m, l, o);
  const u16* vt = (const u16*)(p.ws + OFF_VTB) + (size_t)bg * 64 * 4096;
  banded_attn<128>(qf, (const u16*)(p.ws + OFF_KB) + (size_t)bg * 4096 * 64, t0, vt, lane, slope, m, l, o);
  u16* OB = (u16*)(p.ws + OFF_H) + (size_t)T_TOK * 512;
#pragma unroll
  for (int nt = 0; nt < 4; ++nt) {
    float lt = quad_sum(l[nt]) + ex2(p.sinks[g * 4 + nt] * 1.44269504f - m[nt]);
    float inv = 1.f / lt;
#pragma unroll
    for (int dt = 0; dt < 4; ++dt) {
      const int col = (g * 4 + nt) * 64 + dt * 16 + quad * 4;
      u32x2 z = *(const u32x2*)(P + grow * LDP + C_ZB + col);
      u32x2 ov = {pack2(o[dt][nt][0] * inv * bflo(z.x), o[dt][nt][1] * inv * bfhi(z.x)),
                  pack2(o[dt][nt][2] * inv * bflo(z.y), o[dt][nt][3] * inv * bfhi(z.y))};
      *(u32x2*)(OB + grow * 512 + col) = ov;
    }
  }
}

__device__ void phase4(const Params& p, char* smem) {
  for (int item = blockIdx.x; item < 256; item += gridDim.x) nsa_item(p, 255 - item, smem);
}


__device__ void phase3b(const Params& p, char* smem) {
  for (int item = blockIdx.x; item < 256; item += gridDim.x) swa_item(p, item, smem);
}
template <int PASS>
struct Epi5a {
  static constexpr bool HASMID = false;
  const u16* P; u16* U;
  DI void mid(f32x4 (&)[2][2][4][2], const pg8::Unit&, int, int, int, int) const {}
  DI void operator()(const f32x4 (&acc)[2][2][4][2], const pg8::Unit& u, int wr, int wc, int fr, int fq) const {
#pragma unroll
    for (int ai = 0; ai < 2; ++ai)
#pragma unroll
      for (int m = 0; m < 4; ++m) {
        const int tok = u.pm * 256 + ai * 128 + wr * 64 + m * 16 + fr;
#pragma unroll
        for (int bj = 0; bj < 2; ++bj)
#pragma unroll
          for (int n = 0; n < 2; ++n) {
            const int col = u.pn * 256 + bj * 128 + wc * 32 + n * 16 + 4 * fq;
            u32x2 gt = *(const u32x2*)(P + (size_t)tok * LDP + (PASS == 0 ? C_MA : C_MB) + col);
            const f32x4 a = acc[ai][bj][m][n];
            float v0 = a[0] * bflo(gt.x), v1 = a[1] * bfhi(gt.x), v2 = a[2] * bflo(gt.y), v3 = a[3] * bfhi(gt.y);
            if (PASS == 1) {
              u32x2 pr = *(const u32x2*)(U + (size_t)tok * 1024 + col);
              v0 += bflo(pr.x); v1 += bfhi(pr.x); v2 += bflo(pr.y); v3 += bfhi(pr.y);
            }
            u32x2 ov = {pack2(v0, v1), pack2(v2, v3)};
            *(u32x2*)(U + (size_t)tok * 1024 + col) = ov;
          }
      }
  }
};
__device__ void phase5a(const Params& p, char* smem) {
  const u16* OA = (const u16*)(p.ws + OFF_H);
  pg8::StaticOrder S;
  S.init(T_TOK, 1024, (int)gridDim.x, (int)blockIdx.x);
  {
    pg8::Gemm g{OA, (const u16*)(p.ws + OFF_WTOA), nullptr, nullptr, T_TOK, 1024, 512};
    Epi5a<0> E{(const u16*)(p.ws + OFF_P), (u16*)(p.ws + OFF_U)};
    __syncthreads();
    pg8::gemm_phase((PG8_LAS unsigned char*)smem, g, S, E);
  }
  {
    pg8::Gemm g{OA + (size_t)T_TOK * 512, (const u16*)(p.ws + OFF_WTOB), nullptr, nullptr, T_TOK, 1024, 512};
    Epi5a<1> E{(const u16*)(p.ws + OFF_P), (u16*)(p.ws + OFF_U)};
    __syncthreads();
    pg8::gemm_phase((PG8_LAS unsigned char*)smem, g, S, E);
  }
}

struct Epi5b {
  static constexpr bool HASMID = false;
  u16* Y;
  DI void mid(f32x4 (&)[2][2][4][2], const pg8::Unit&, int, int, int, int) const {}
  DI void operator()(const f32x4 (&acc)[2][2][4][2], const pg8::Unit& u, int wr, int wc, int fr, int fq) const {
#pragma unroll
    for (int ai = 0; ai < 2; ++ai)
#pragma unroll
      for (int m = 0; m < 4; ++m) {
        const int tok = u.pm * 256 + ai * 128 + wr * 64 + m * 16 + fr;
#pragma unroll
        for (int bj = 0; bj < 2; ++bj)
#pragma unroll
          for (int n = 0; n < 2; ++n) {
            const int col = u.pn * 256 + bj * 128 + wc * 32 + n * 16 + 4 * fq;
            const f32x4 a = acc[ai][bj][m][n];
            u32x2 ov = {pack2(a[0], a[1]), pack2(a[2], a[3])};
            *(u32x2*)(Y + (size_t)tok * 1024 + col) = ov;
          }
      }
  }
};
__device__ void phase5b(const Params& p, char* smem) {
  pg8::Gemm g{(const u16*)(p.ws + OFF_U), (const u16*)(p.ws + OFF_WTOUT), nullptr, nullptr, T_TOK, 1024, 1024};
  pg8::StaticOrder S;
  S.init(g.M, g.N, (int)gridDim.x, (int)blockIdx.x);
  Epi5b E{(u16*)(p.ws + OFF_P)};
  __syncthreads();
  pg8::gemm_phase((PG8_LAS unsigned char*)smem, g, S, E);
}

__device__ void phase5c(const Params& p, char* smem) {
  const int t = threadIdx.x, lane = t & 63, wave = t >> 6;
  float* gg = (float*)smem;
  const u16* Y = (const u16*)(p.ws + OFF_P);
  for (int row0 = blockIdx.x * 64; row0 < T_TOK; row0 += gridDim.x * 64) {
    const int b = row0 >> 12;
    __syncthreads();
    for (int c = t; c < 1024; c += 512) gg[c] = p.g_post[c] * mod_value(p, b, 2048 + c);
    __syncthreads();
#pragma unroll 2
    for (int rr = 0; rr < 8; ++rr) {
      const int row = row0 + wave * 8 + rr;
      const u32x4* yr = (const u32x4*)(Y + (size_t)row * 1024);
      const float4* xr = (const float4*)(p.x + (size_t)row * 1024);
      float v[16];
      float ss = 0.f;
#pragma unroll
      for (int i = 0; i < 2; ++i) {
        u32x4 u = yr[lane + 64 * i];
        v[i * 8 + 0] = bflo(u.x); v[i * 8 + 1] = bfhi(u.x); v[i * 8 + 2] = bflo(u.y); v[i * 8 + 3] = bfhi(u.y);
        v[i * 8 + 4] = bflo(u.z); v[i * 8 + 5] = bfhi(u.z); v[i * 8 + 6] = bflo(u.w); v[i * 8 + 7] = bfhi(u.w);
      }
#pragma unroll
      for (int i = 0; i < 16; ++i) ss += v[i] * v[i];
      ss = wave_sum(ss);
      const float rstd = rsqrtf(ss * (1.f / 1024.f) + 1e-6f);
#pragma unroll
      for (int i = 0; i < 2; ++i)
#pragma unroll
        for (int hh = 0; hh < 2; ++hh) {
          const int c4 = (lane + 64 * i) * 2 + hh;
          float4 g = ((const float4*)gg)[c4];
          float4 xv = xr[c4];
          float4 o;
          o.x = xv.x + g.x * (v[i * 8 + hh * 4 + 0] * rstd);
          o.y = xv.y + g.y * (v[i * 8 + hh * 4 + 1] * rstd);
          o.z = xv.z + g.z * (v[i * 8 + hh * 4 + 2] * rstd);
          o.w = xv.w + g.w * (v[i * 8 + hh * 4 + 3] * rstd);
          ((float4*)(p.out + (size_t)row * 1024))[c4] = o;
        }
    }
  }
}
DI void grid_barrier(unsigned* counter, unsigned target) {
  asm volatile("s_waitcnt vmcnt(0) lgkmcnt(0)" ::: "memory");
  __syncthreads();
  if (threadIdx.x == 0) {
    __threadfence();
    asm volatile("s_waitcnt vmcnt(0)" ::: "memory");
    __hip_atomic_fetch_add(counter, 1u, __ATOMIC_RELAXED, __HIP_MEMORY_SCOPE_AGENT);
    while (__hip_atomic_load(counter, __ATOMIC_RELAXED, __HIP_MEMORY_SCOPE_AGENT) < target) __builtin_amdgcn_s_sleep(2);
    __threadfence();
  }
  __syncthreads();
}

extern __shared__ __attribute__((aligned(16))) char smem[];
__global__ void __launch_bounds__(512) mk(Params p) {
  cg::grid_group grid = cg::this_grid();
  unsigned* bar = (unsigned*)(p.ws + OFF_BAR);
  const unsigned nb = gridDim.x;
  if (p.ws == nullptr) grid.sync();
  phase0<0>(p, smem);
  grid_barrier(bar, nb);
  phase1(p, smem);
  phase0<1>(p, smem);
  grid_barrier(bar, 2 * nb);
  phase2(p, smem);
  grid_barrier(bar, 3 * nb);
  phase3(p, smem);
  phase3b(p, smem);
  grid_barrier(bar, 4 * nb);
  phase4(p, smem);
  grid_barrier(bar, 5 * nb);
  phase5a(p, smem);
  grid_barrier(bar, 6 * nb);
  phase5b(p, smem);
  grid_barrier(bar, 7 * nb);
  phase5c(p, smem);
}

extern "C" void kernel_launch(void* const* d_in, const int* in_sizes, int n_in, void* d_out, int out_size,
                              void* d_ws, size_t ws_size, hipStream_t stream) {
  static int grid_blocks = 0;
  if (!grid_blocks) {
    int dev = 0, cus = 0, per_cu = 0;
    (void)hipGetDevice(&dev);
    (void)hipDeviceGetAttribute(&cus, hipDeviceAttributeMultiprocessorCount, dev);
    (void)hipFuncSetAttribute((const void*)mk, hipFuncAttributeMaxDynamicSharedMemorySize, SMEM_BYTES);
    (void)hipOccupancyMaxActiveBlocksPerMultiprocessor(&per_cu, mk, 512, SMEM_BYTES);
    if (per_cu > 1) per_cu = 1;
    if (per_cu < 1) per_cu = 1;
    grid_blocks = cus * per_cu;
  }
  if (ws_size < WS_NEED) fprintf(stderr, "workspace too small: %zu < %zu\n", ws_size, (size_t)WS_NEED);
  Params p{};
  const float* const* in = (const float* const*)d_in;
  p.x = in[0]; p.c = in[1]; p.w_ada = in[2]; p.b_ada = in[3]; p.g_pre = in[4]; p.g_post = in[5]; p.w_in = in[6];
  p.pe_k = in[7]; p.pe_v = in[8]; p.w1k = in[9]; p.w2k = in[10]; p.w1v = in[11]; p.w2v = in[12];
  p.w_o_nsa = in[13]; p.w_o_swa = in[14]; p.w_out = in[15]; p.sinks = in[16];
  p.out = (float*)d_out;
  p.ws = (char*)d_ws;
  (void)hipMemsetAsync((char*)d_ws + OFF_BAR, 0, 256, stream);
  void* args[] = {&p};
  hipError_t e = hipLaunchCooperativeKernel((void*)mk, dim3(grid_blocks), dim3(512), args, SMEM_BYTES, stream);
  if (e != hipSuccess) fprintf(stderr, "cooperative launch failed: %s (grid %d)\n", hipGetErrorString(e), grid_blocks);
}
```
